# Optimizing an MI355X kernel written in HIP

```python
import math
import jax, jax.numpy as jnp
from jax import lax
import numpy as np

D_MODEL = 1024
BATCH = 4
SEQ = 8192
DEPTH = 4

S5_CHANNELS = D_MODEL // 2
S5_GROUP = 16
S5_GROUPS = S5_CHANNELS // S5_GROUP
S5_STATE = 64
DT_MIN = 1e-3
DT_MAX = 1e-1
DIL_WIDTH = D_MODEL // 2
DIL_HEAD_DIM = 64
DIL_HEADS = DIL_WIDTH // DIL_HEAD_DIM
DIL_PATTERNS = ((128, 1), (512, 4), (2048, 16))
BAND_BLOCK = 128
DIFF_HEAD_DIM = 64
DIFF_HEADS = D_MODEL // (2 * DIFF_HEAD_DIM)
DIFF_WIDTH = DIFF_HEADS * 2 * DIFF_HEAD_DIM
QUERY_BLOCK = 128
NUM_BUCKETS = 32
MAX_DISTANCE = 2048
BIAS_HEADS = DIL_HEADS + DIFF_HEADS
D_FF = -(-(8 * D_MODEL) // (3 * 256)) * 256
N_EVEN = (DEPTH + 1) // 2
N_ODD = DEPTH // 2
EVEN_IN = S5_CHANNELS + 3 * DIL_WIDTH
EVEN_OUT = S5_CHANNELS + DIL_WIDTH
EPS = 1e-6
NEG_INF = -1e30

kernel_name = "hybrid_s5_dilated_diffattn_trunk"


def rms_norm(x, g):
    xf = x.astype(jnp.float32)
    inv = lax.rsqrt(jnp.mean(xf * xf, axis=-1, keepdims=True) + EPS)
    return (xf * inv).astype(x.dtype) * g


def rel_bucket(dist):
    max_exact = NUM_BUCKETS // 2
    d = jnp.maximum(dist, 0)
    scaled = (jnp.log(jnp.maximum(d, 1).astype(jnp.float32) / max_exact)
              / math.log(MAX_DISTANCE / max_exact) * (NUM_BUCKETS - max_exact))
    large = jnp.minimum(max_exact + scaled.astype(jnp.int32), NUM_BUCKETS - 1)
    return jnp.where(d < max_exact, d, large)


def swiglu(h, w_gate, w_up, w_down):
    return (jax.nn.silu(h @ w_gate) * (h @ w_up)) @ w_down


def s5_mixer(u, lam_re, lam_im, log_dt, b_re, b_im, c_re, c_im, d_skip, glu_w, glu_b):
    f32 = jnp.float32
    bn, s, _ = u.shape
    uf = u.astype(f32).reshape(bn, s, S5_GROUPS, S5_GROUP)
    lr = lam_re.astype(f32)
    li = lam_im.astype(f32)
    dt = jnp.exp(log_dt.astype(f32))[:, None]
    mag = jnp.exp(lr * dt)
    ar = mag * jnp.cos(li * dt)
    ai = mag * jnp.sin(li * dt)
    nr, ni = ar - 1.0, ai
    den = lr * lr + li * li
    cr = ((nr * lr + ni * li) / den)[..., None]
    ci = ((ni * lr - nr * li) / den)[..., None]
    br, bi = b_re.astype(f32), b_im.astype(f32)
    bbar_r = cr * br - ci * bi
    bbar_i = cr * bi + ci * br
    xr = jnp.einsum('bsgc,gpc->bsgp', uf, bbar_r)
    xi = jnp.einsum('bsgc,gpc->bsgp', uf, bbar_i)
    a_r = jnp.broadcast_to(ar, (1, s, S5_GROUPS, S5_STATE))
    a_i = jnp.broadcast_to(ai, (1, s, S5_GROUPS, S5_STATE))

    def combine(left, right):
        a1r, a1i, b1r, b1i = left
        a2r, a2i, b2r, b2i = right
        return (a2r * a1r - a2i * a1i,
                a2r * a1i + a2i * a1r,
                a2r * b1r - a2i * b1i + b2r,
                a2r * b1i + a2i * b1r + b2i)

    _, _, hr, hi = lax.associative_scan(combine, (a_r, a_i, xr, xi), axis=1)
    y = (jnp.einsum('bsgp,gcp->bsgc', hr, c_re.astype(f32))
         - jnp.einsum('bsgp,gcp->bsgc', hi, c_im.astype(f32)))
    y = y + d_skip.astype(f32).reshape(S5_GROUPS, S5_GROUP) * uf
    y = jax.nn.gelu(y.reshape(bn, s, S5_CHANNELS))
    y = y * jax.nn.sigmoid(y @ glu_w.astype(f32) + glu_b.astype(f32))
    return y.astype(u.dtype)


def dilated_branch(q, k, v, table, window, dilation):
    f32 = jnp.float32
    bn, s, h, hd = q.shape
    length = s // dilation
    n_blk = -(-length // BAND_BLOCK)
    lp = n_blk * BAND_BLOCK
    span = window // dilation

    def to_blocks(t):
        t = t.reshape(bn, length, dilation, h, -1).transpose(0, 2, 1, 3, 4)
        t = jnp.pad(t, ((0, 0), (0, 0), (0, lp - length), (0, 0), (0, 0)))
        return t.reshape(bn, dilation, n_blk, BAND_BLOCK, h, t.shape[-1])

    def with_prev(t):
        prev = jnp.pad(t, ((0, 0), (0, 0), (1, 0), (0, 0), (0, 0), (0, 0)))[:, :, :-1]
        return jnp.concatenate([prev, t], axis=3)

    qb = to_blocks(q)
    kb = with_prev(to_blocks(k))
    vb = with_prev(to_blocks(v))
    logits = jnp.einsum('brnqhe,brnkhe->brnhqk', qb, kb).astype(f32) * (hd ** -0.5)
    qi = jnp.arange(BAND_BLOCK)[:, None]
    kc = jnp.arange(2 * BAND_BLOCK)[None, :]
    steps = BAND_BLOCK + qi - kc
    in_band = (steps >= 0) & (steps <= span)
    exists = (jnp.arange(n_blk)[:, None, None] > 0) | (kc >= BAND_BLOCK)[None]
    mask = in_band[None] & exists
    bucket = rel_bucket(jnp.clip(steps, 0, span) * dilation)
    bias = jnp.transpose(table[bucket], (2, 0, 1)).astype(f32)
    logits = jnp.where(mask[None, None, :, None], logits + bias, NEG_INF)
    m = jnp.max(logits, axis=-1, keepdims=True)
    p = jnp.exp(logits - m)
    den = jnp.sum(p, axis=-1, keepdims=True)
    o = jnp.einsum('brnhqk,brnkhe->brnqhe', (p / den).astype(v.dtype), vb)
    lse = jnp.swapaxes((m + jnp.log(den))[..., 0], -1, -2)

    def from_blocks(t):
        t = t.reshape(bn, dilation, lp, h, -1)[:, :, :length]
        return t.transpose(0, 2, 1, 3, 4).reshape(bn, s, h, -1)

    return from_blocks(o.astype(f32)), from_blocks(lse[..., None])[..., 0]


def dilated_attention(q, k, v, table):
    outs, lses = [], []
    for window, dilation in DIL_PATTERNS:
        o, lse = dilated_branch(q, k, v, table, window, dilation)
        outs.append(o)
        lses.append(lse)
    alpha = jax.nn.softmax(jnp.stack(lses), axis=0)
    o = jnp.sum(alpha[..., None] * jnp.stack(outs), axis=0)
    return o.astype(q.dtype)


def diff_attention(q1, q2, k1, k2, v, table, lam):
    f32 = jnp.float32
    bn, s, h, hd = q1.shape
    n_blk = s // QUERY_BLOCK
    scale = hd ** -0.5
    kpos = jnp.arange(s)

    def to_blocks(t):
        return jnp.moveaxis(t.reshape(bn, n_blk, QUERY_BLOCK, h, hd), 1, 0)

    def one_block(args):
        q1b, q2b, start = args
        dist = (start + jnp.arange(QUERY_BLOCK))[:, None] - kpos[None, :]
        causal = dist >= 0
        bias = jnp.transpose(table[rel_bucket(dist)], (2, 0, 1)).astype(f32)

        def probs(qb, kk):
            lg = jnp.einsum('bqhe,bkhe->bhqk', qb, kk).astype(f32) * scale + bias
            return jax.nn.softmax(jnp.where(causal, lg, NEG_INF), axis=-1)

        a = probs(q1b, k1) - lam * probs(q2b, k2)
        return jnp.einsum('bhqk,bkhe->bqhe', a.astype(v.dtype), v)

    starts = jnp.arange(n_blk) * QUERY_BLOCK
    out = lax.map(one_block, (to_blocks(q1), to_blocks(q2), starts))
    return jnp.moveaxis(out, 0, 1).reshape(bn, s, h, 2 * hd)


def setup_inputs(seed: int = 0) -> dict:
    key = jax.random.key(seed)
    ks = jax.random.split(key, 32)
    f32 = jnp.float32
    nrm = lambda k, shape, scale: jax.random.normal(k, shape, f32) * scale
    n_idx = jnp.arange(S5_STATE, dtype=f32)
    return {
        "x": jax.random.normal(ks[0], (BATCH, SEQ, D_MODEL), f32),
        "rel_bias": nrm(ks[1], (NUM_BUCKETS, BIAS_HEADS), 0.2),
        "norm_mix": 1.0 + nrm(ks[2], (DEPTH, D_MODEL), 0.02),
        "norm_ffn": 1.0 + nrm(ks[3], (DEPTH, D_MODEL), 0.02),
        "norm_final": 1.0 + nrm(ks[4], (D_MODEL,), 0.02),
        "ffn_w_gate": nrm(ks[5], (DEPTH, D_MODEL, D_FF), D_MODEL ** -0.5),
        "ffn_w_up": nrm(ks[6], (DEPTH, D_MODEL, D_FF), D_MODEL ** -0.5),
        "ffn_w_down": nrm(ks[7], (DEPTH, D_FF, D_MODEL), D_FF ** -0.5),
        "even_w_in": nrm(ks[8], (N_EVEN, D_MODEL, EVEN_IN), D_MODEL ** -0.5),
        "even_w_out": nrm(ks[9], (N_EVEN, EVEN_OUT, D_MODEL), EVEN_OUT ** -0.5),
        "s5_lambda_re": -0.5 + nrm(ks[10], (N_EVEN, S5_GROUPS, S5_STATE), 0.01),
        "s5_lambda_im": math.pi * n_idx + nrm(ks[11], (N_EVEN, S5_GROUPS, S5_STATE), 0.01),
        "s5_log_dt": jax.random.uniform(ks[12], (N_EVEN, S5_GROUPS), f32,
                                        math.log(DT_MIN), math.log(DT_MAX)),
        "s5_b_re": nrm(ks[13], (N_EVEN, S5_GROUPS, S5_STATE, S5_GROUP), (2 * S5_GROUP) ** -0.5),
        "s5_b_im": nrm(ks[14], (N_EVEN, S5_GROUPS, S5_STATE, S5_GROUP), (2 * S5_GROUP) ** -0.5),
        "s5_c_re": nrm(ks[15], (N_EVEN, S5_GROUPS, S5_GROUP, S5_STATE), (2 * S5_STATE) ** -0.5),
        "s5_c_im": nrm(ks[16], (N_EVEN, S5_GROUPS, S5_GROUP, S5_STATE), (2 * S5_STATE) ** -0.5),
        "s5_d": nrm(ks[17], (N_EVEN, S5_CHANNELS), 1.0),
        "s5_glu_w": nrm(ks[18], (N_EVEN, S5_CHANNELS, S5_CHANNELS), S5_CHANNELS ** -0.5),
        "s5_glu_b": nrm(ks[19], (N_EVEN, S5_CHANNELS), 0.02),
        "odd_w_in": nrm(ks[20], (N_ODD, D_MODEL, 3 * DIFF_WIDTH), D_MODEL ** -0.5),
        "odd_w_out": nrm(ks[21], (N_ODD, DIFF_WIDTH, D_MODEL), DIFF_WIDTH ** -0.5),
        "diff_lambda_q1": nrm(ks[22], (N_ODD, DIFF_HEAD_DIM), 0.1),
        "diff_lambda_k1": nrm(ks[23], (N_ODD, DIFF_HEAD_DIM), 0.1),
        "diff_lambda_q2": nrm(ks[24], (N_ODD, DIFF_HEAD_DIM), 0.1),
        "diff_lambda_k2": nrm(ks[25], (N_ODD, DIFF_HEAD_DIM), 0.1),
        "diff_subln": 1.0 + nrm(ks[26], (N_ODD, 2 * DIFF_HEAD_DIM), 0.02),
    }


def reference(x, rel_bias, norm_mix, norm_ffn, norm_final, ffn_w_gate, ffn_w_up, ffn_w_down,
              even_w_in, even_w_out, s5_lambda_re, s5_lambda_im, s5_log_dt, s5_b_re, s5_b_im,
              s5_c_re, s5_c_im, s5_d, s5_glu_w, s5_glu_b, odd_w_in, odd_w_out,
              diff_lambda_q1, diff_lambda_k1, diff_lambda_q2, diff_lambda_k2, diff_subln):
    bn, s, _ = x.shape
    table_dil = rel_bias[:, :DIL_HEADS]
    table_diff = rel_bias[:, DIL_HEADS:]
    for layer in range(DEPTH):
        h = rms_norm(x, norm_mix[layer])
        if layer % 2 == 0:
            e = layer // 2
            z = h @ even_w_in[e]
            u = z[..., :S5_CHANNELS]
            q, k, v = jnp.split(z[..., S5_CHANNELS:], 3, axis=-1)
            y_a = s5_mixer(u, s5_lambda_re[e], s5_lambda_im[e], s5_log_dt[e], s5_b_re[e],
                           s5_b_im[e], s5_c_re[e], s5_c_im[e], s5_d[e], s5_glu_w[e], s5_glu_b[e])
            hs = (bn, s, DIL_HEADS, DIL_HEAD_DIM)
            y_b = dilated_attention(q.reshape(hs), k.reshape(hs), v.reshape(hs), table_dil)
            mixed = jnp.concatenate([y_a, y_b.reshape(bn, s, DIL_WIDTH)], axis=-1)
            x = x + mixed @ even_w_out[e]
        else:
            o = layer // 2
            lam_init = 0.8 - 0.6 * math.exp(-0.3 * layer)
            z = h @ odd_w_in[o]
            q, k, v = jnp.split(z, 3, axis=-1)
            q = q.reshape(bn, s, DIFF_HEADS, 2, DIFF_HEAD_DIM)
            k = k.reshape(bn, s, DIFF_HEADS, 2, DIFF_HEAD_DIM)
            v = v.reshape(bn, s, DIFF_HEADS, 2 * DIFF_HEAD_DIM)
            lam = (jnp.exp(jnp.sum(diff_lambda_q1[o].astype(jnp.float32) * diff_lambda_k1[o].astype(jnp.float32)))
                   - jnp.exp(jnp.sum(diff_lambda_q2[o].astype(jnp.float32) * diff_lambda_k2[o].astype(jnp.float32)))
                   + lam_init)
            att = diff_attention(q[..., 0, :], q[..., 1, :], k[..., 0, :], k[..., 1, :], v,
                                 table_diff, lam)
            att = rms_norm(att, diff_subln[o]) * (1.0 - lam_init)
            x = x + att.reshape(bn, s, DIFF_WIDTH) @ odd_w_out[o]
        x = x + swiglu(rms_norm(x, norm_ffn[layer]), ffn_w_gate[layer], ffn_w_up[layer],
                       ffn_w_down[layer])
    return rms_norm(x, norm_final)
```

```cpp
#include <hip/hip_runtime.h>
#include <hip/hip_cooperative_groups.h>
#include <cstdio>
#include <cstdint>
namespace cg = cooperative_groups;

#define LAS __attribute__((address_space(3)))
typedef unsigned short bf16_t;
typedef short bf16x8 __attribute__((ext_vector_type(8)));
typedef short s16x4 __attribute__((ext_vector_type(4)));
typedef float f32x4 __attribute__((ext_vector_type(4)));
typedef float f32x16 __attribute__((ext_vector_type(16)));
typedef unsigned u32x4 __attribute__((ext_vector_type(4)));
typedef unsigned u32x2 __attribute__((ext_vector_type(2)));

namespace pg8 {
constexpr int BM = 256, BK = 64, HALF = 128, HTB = HALF * BK * 2, STAGE_BYTES = 8 * HTB, NXCD = 8, WGM = 8;
__host__ __device__ __forceinline__ int lds_byte(int r, int c) { const int st = (r >> 4) * 2 + (c >> 5), rr = r & 15, cc = c & 31, ob = rr * 64 + cc * 2; return st * 1024 + (ob ^ (((ob >> 9) & 1) << 5)); }
__host__ __device__ __forceinline__ void stage_rc(int b, int& R, int& C) { const int st = b / 1024, sb = b % 1024, swz = sb ^ (((sb >> 9) & 1) << 5); R = (st >> 1) * 16 + swz / 64; C = (st & 1) * 32 + (swz % 64) / 2; }
__host__ __device__ __forceinline__ int perm32(int rho) { const int n = rho >> 4, i = rho & 15; return 8 * (i >> 2) + 4 * n + (i & 3); }

struct Unit { int pm, pn; };
struct Gemm { const bf16_t* A; const bf16_t* Bt; int lda, ldb, K; };

struct StaticOrder {
    int nM, nN, nwg, G, c;
    __host__ __device__ void init(int M, int N, int G_, int c_) { nM = M / BM; nN = N / BM; nwg = nM * nN; G = G_; c = c_; }
    __host__ __device__ bool next(int i, Unit& u) const {
        const long L = (long)i * G + c; if (L >= nwg) return false;
        int wgid = (int)L; { const int q = nwg / NXCD, r = nwg % NXCD, xcd = wgid % NXCD, off = wgid / NXCD; wgid = (xcd < r ? xcd * (q + 1) : r * (q + 1) + (xcd - r) * q) + off; }
        const int nig = WGM * nN, gid = wgid / nig, fm = gid * WGM, gsz = (nM - fm) < WGM ? (nM - fm) : WGM;
        u.pm = fm + ((wgid % nig) % gsz); u.pn = (wgid % nig) / gsz; return true;
    }
    __device__ __forceinline__ void a_ready(const Unit&) const {}
    __device__ __forceinline__ void done(const Unit&) const {}
};
struct GroupOrder {
    int total, G, c, mi, nj;
    __device__ bool next(int i, Unit& u) const {
        const int L = i * G + c; if (L >= total) return false;
        const int per = mi * nj, g = L / per, r = L % per; u.pm = g * mi + r % mi; u.pn = g * nj + r / mi; return true;
    }
    __device__ __forceinline__ void a_ready(const Unit&) const {}
    __device__ __forceinline__ void done(const Unit&) const {}
};

__device__ __forceinline__ unsigned cvt_pk_bf16(float lo, float hi) { unsigned r; asm volatile("v_cvt_pk_bf16_f32 %0, %1, %2" : "=v"(r) : "v"(lo), "v"(hi)); return r; }

template <class Epi, class Sched>
__device__ __forceinline__ void gemm_phase(LAS unsigned char* lds, const Gemm g, const Sched& S, const Epi& E) {
    int tid_ = threadIdx.x; asm volatile("" : "+v"(tid_));
    const int tid = tid_, wid = __builtin_amdgcn_readfirstlane(tid >> 6), lane = tid & 63, wr = wid >> 2, wc = wid & 3, fr = lane & 15, fq = lane >> 4;
    const int K = g.K, nt = K / BK;
    unsigned voffA[2], voffB[2];
#pragma unroll
    for (int i = 0; i < 2; ++i) { int R, C; stage_rc(tid * 16 + i * 8192, R, C); const int Rb = Epi::PERM ? ((R & ~31) + perm32(R & 31)) : R;
        voffA[i] = (unsigned)(R * g.lda + C) * 2u; voffB[i] = (unsigned)(Rb * g.ldb + C) * 2u; }
    const size_t kstep = (size_t)(BK * 2);
    const size_t hstepA = (size_t)HALF * g.lda * 2, hstepB = (size_t)HALF * g.ldb * 2;
    const size_t tstepA = 2 * hstepA, tstepB = 2 * hstepB;
    const unsigned ldsw = (unsigned)wid * 1024u;
    const int aoff = lds_byte(wr * 64 + fr, fq * 8), boff = lds_byte(wc * 32 + fr, fq * 8);
#define PG8_SA(b, h) (((b) * 2 + (h)) * HTB)
#define PG8_SB(b, h) ((4 + (b) * 2 + (h)) * HTB)
#define PG8_STAGE(bufoff, gbase, voff) do { _Pragma("unroll") for (int _i = 0; _i < 2; ++_i) \
        __builtin_amdgcn_global_load_lds((const unsigned*)((const char*)(gbase) + (voff)[_i]), (LAS unsigned*)(lds + (bufoff) + ldsw + _i * 8192), 16, 0, 0); } while (0)
#define PG8_LDA(dst, b, h) do { _Pragma("unroll") for (int m = 0; m < 4; ++m) _Pragma("unroll") for (int k = 0; k < 2; ++k) dst[m][k] = *(const LAS bf16x8*)(lds + PG8_SA(b, h) + aoff + m * 2048 + k * 1024); } while (0)
#define PG8_LDB(dst, b, h) do { _Pragma("unroll") for (int n = 0; n < 2; ++n) _Pragma("unroll") for (int k = 0; k < 2; ++k) dst[n][k] = *(const LAS bf16x8*)(lds + PG8_SB(b, h) + boff + n * 2048 + k * 1024); } while (0)
#define PG8_MMA(ai, bj, At, Bt) do { __builtin_amdgcn_s_setprio(1); _Pragma("unroll") for (int m = 0; m < 4; ++m) _Pragma("unroll") for (int n = 0; n < 2; ++n) _Pragma("unroll") for (int k = 0; k < 2; ++k) \
        acc[ai][bj][m][n] = __builtin_amdgcn_mfma_f32_16x16x32_bf16(Bt[n][k], At[m][k], acc[ai][bj][m][n], 0, 0, 0); __builtin_amdgcn_s_setprio(0); } while (0)
#define PG8_WAIT_V(n) asm volatile("s_waitcnt vmcnt(" #n ")" ::: "memory")
#define PG8_WAIT_L(n) asm volatile("s_waitcnt lgkmcnt(" #n ")" ::: "memory")
#define PG8_BAR __builtin_amdgcn_s_barrier()
#define PG8_SCHED __builtin_amdgcn_sched_barrier(0)
    Unit cur, nxt; int ui = 0;
    if (!S.next(0, cur)) return;
    f32x4 acc[2][2][4][2];
#pragma unroll
    for (int a = 0; a < 2; ++a)
#pragma unroll
        for (int b = 0; b < 2; ++b)
#pragma unroll
            for (int m = 0; m < 4; ++m)
#pragma unroll
                for (int n = 0; n < 2; ++n) acc[a][b][m][n] = (f32x4){0.f, 0.f, 0.f, 0.f};
    bf16x8 At[4][2], B0[2][2], B1[2][2];
    const char* cA = (const char*)g.A + (size_t)cur.pm * tstepA; const char* cB = (const char*)g.Bt + (size_t)cur.pn * tstepB;
    S.a_ready(cur);
    PG8_STAGE(PG8_SB(0, 0), cB, voffB); PG8_STAGE(PG8_SB(0, 1), cB + hstepB, voffB); PG8_STAGE(PG8_SA(0, 0), cA, voffA); PG8_STAGE(PG8_SA(0, 1), cA + hstepA, voffA);
    if (wr == 1) PG8_BAR;
    PG8_WAIT_V(2); PG8_BAR;
    PG8_STAGE(PG8_SB(1, 0), cB + kstep, voffB); PG8_STAGE(PG8_SA(1, 0), cA + kstep, voffA); PG8_STAGE(PG8_SB(1, 1), cB + hstepB + kstep, voffB);
    PG8_WAIT_V(6); PG8_BAR;
    for (;;) {
        const bool has_next = S.next(ui + 1, nxt);
        const char* nA = has_next ? (const char*)g.A + (size_t)nxt.pm * tstepA : cA; const char* nB = has_next ? (const char*)g.Bt + (size_t)nxt.pn * tstepB : cB;
        for (int t = 0; t < nt; t += 2) {
            const bool last = (t == nt - 2);
            const char* a1 = cA + (size_t)(t + 1) * kstep;
            const char* a2 = last ? nA : cA + (size_t)(t + 2) * kstep; const char* b2 = last ? nB : cB + (size_t)(t + 2) * kstep;
            const char* a3 = a2 + kstep; const char* b3 = b2 + kstep;
            if (last && has_next) S.a_ready(nxt);
            PG8_LDB(B0, 0, 0); PG8_LDB(B1, 0, 1); PG8_SCHED; PG8_LDA(At, 0, 0); PG8_STAGE(PG8_SA(1, 1), a1 + hstepA, voffA);
            PG8_WAIT_V(8); PG8_WAIT_L(0); PG8_BAR; PG8_MMA(0, 0, At, B0); PG8_MMA(0, 1, At, B1); PG8_BAR; PG8_SCHED;
            PG8_LDA(At, 0, 1); PG8_STAGE(PG8_SB(0, 0), b2, voffB); PG8_STAGE(PG8_SB(0, 1), b2 + hstepB, voffB); PG8_STAGE(PG8_SA(0, 0), a2, voffA);
            PG8_WAIT_V(8); PG8_WAIT_L(0); PG8_BAR; PG8_MMA(1, 0, At, B0); PG8_MMA(1, 1, At, B1); PG8_BAR; PG8_SCHED;
            PG8_LDB(B0, 1, 0); PG8_LDB(B1, 1, 1); PG8_SCHED; PG8_LDA(At, 1, 0); PG8_STAGE(PG8_SA(0, 1), a2 + hstepA, voffA);
            PG8_WAIT_V(8); PG8_WAIT_L(0); PG8_BAR; PG8_MMA(0, 0, At, B0); PG8_MMA(0, 1, At, B1); PG8_BAR; PG8_SCHED;
            PG8_LDA(At, 1, 1); PG8_STAGE(PG8_SB(1, 0), b3, voffB); PG8_STAGE(PG8_SB(1, 1), b3 + hstepB, voffB); PG8_STAGE(PG8_SA(1, 0), a3, voffA);
            PG8_WAIT_V(8); PG8_WAIT_L(0); PG8_BAR; PG8_MMA(1, 0, At, B0); PG8_MMA(1, 1, At, B1); PG8_BAR; PG8_SCHED;
        }
        if (wr == 0) PG8_BAR;
        E(acc, cur, wr, wc, fr, fq); S.done(cur);
        if (!has_next) break;
#pragma unroll
        for (int a = 0; a < 2; ++a)
#pragma unroll
            for (int b = 0; b < 2; ++b)
#pragma unroll
                for (int m = 0; m < 4; ++m)
#pragma unroll
                    for (int n = 0; n < 2; ++n) acc[a][b][m][n] = (f32x4){0.f, 0.f, 0.f, 0.f};
        cur = nxt; cA = nA; cB = nB; ++ui;
        if (wr == 1) PG8_BAR;
    }
    PG8_WAIT_V(0);
    PG8_BAR;
#undef PG8_SA
#undef PG8_SB
#undef PG8_STAGE
#undef PG8_LDA
#undef PG8_LDB
#undef PG8_MMA
#undef PG8_WAIT_V
#undef PG8_WAIT_L
#undef PG8_BAR
#undef PG8_SCHED
}
}
using pg8::cvt_pk_bf16;

constexpr int NB = 4, SEQ = 8192, DM = 1024, NT = NB * SEQ, DFF = 2816;
constexpr int CH = 32, NCHUNK = NT / CH, CPB = SEQ / CH;
constexpr int UGP = 640;
constexpr float EPS = 1e-6f, LOG2E = 1.4426950408889634f, QSC = 0.125f * 1.4426950408889634f;

constexpr size_t al256(size_t x) { return (x + 255) & ~(size_t)255; }
constexpr size_t SZ_GU = (size_t)5632 * 1024 * 2, SZ_DN = (size_t)1024 * 2816 * 2, SZ_EIN = (size_t)2048 * 1024 * 2, SZ_SQ = (size_t)1024 * 1024 * 2,
                 SZ_GLU = (size_t)512 * 512 * 2, SZ_OIN = (size_t)3072 * 1024 * 2, SZ_BTY = (size_t)32 * 512 * 640 * 2, SZ_BTF = (size_t)32 * 256 * 512 * 2;
constexpr size_t WS_GU = 0, WS_DN = WS_GU + 4 * SZ_GU, WS_EIN = WS_DN + 4 * SZ_DN, WS_EOUT = WS_EIN + 2 * SZ_EIN, WS_GLU = WS_EOUT + 2 * SZ_SQ,
                 WS_OIN = WS_GLU + 2 * SZ_GLU, WS_OOUT = WS_OIN + 2 * SZ_OIN, WS_BTY = WS_OOUT + 2 * SZ_SQ, WS_BTF = WS_BTY + 2 * SZ_BTY,
                 WS_AL = WS_BTF + 2 * SZ_BTF, WS_LUTD = WS_AL + 32768, WS_MISC = WS_LUTD + 69632, WS_BAR = WS_MISC + 16384, WS_SS = WS_BAR + 16384,
                 WS_MIXED = WS_SS + (size_t)NT * 16 * 4, WS_Z = WS_MIXED + (size_t)NT * 1024 * 2,
                 WS_XB = WS_Z + (size_t)NT * 3072 * 2, WS_END = WS_XB + (size_t)3 * NT * 512 * 2 + (size_t)3 * NT * 8 * 4;
constexpr size_t ZO_QKV = 0, ZO_UG = (size_t)NT * 1536 * 2, ZO_SST = ZO_UG + (size_t)32 * 1024 * UGP * 2, ZO_YG = ZO_SST + (size_t)32 * 1024 * 128 * 4;
static_assert(ZO_YG + (size_t)NT * 512 * 2 <= (size_t)NT * 3072 * 2, "even-layer buffers fit the Z region");
static_assert((size_t)NT * DFF * 2 <= (size_t)NT * 3072 * 2, "act fits the Z region");
static_assert(WS_END <= (size_t)4 * NT * 1024 * 4, "workspace within 4x largest tensor");
constexpr int LDS_BYTES = 147456, LDS_BARW = LDS_BYTES - 256;
constexpr bool RES_LO = false;

struct Args {
    const float* in[27]; float* out; unsigned char* ws;
};

__device__ __forceinline__ float bf2f(bf16_t v) { return __uint_as_float(((unsigned)v) << 16); }
__device__ __forceinline__ bf16_t f2bf(float f) { unsigned u = __float_as_uint(f); return (bf16_t)((u + 0x7fffu + ((u >> 16) & 1u)) >> 16); }
__device__ __forceinline__ float wave_sum(float v) {
#pragma unroll
    for (int o = 32; o > 0; o >>= 1) v += __shfl_xor(v, o);
    return v;
}
__device__ __forceinline__ float row_rs(const float* ss, int row) {
    const f32x4* p = (const f32x4*)(ss + (size_t)row * 16);
    const f32x4 a = p[0], b = p[1], c = p[2], d = p[3];
    const float s = ((a[0] + a[1]) + (a[2] + a[3])) + ((b[0] + b[1]) + (b[2] + b[3])) + ((c[0] + c[1]) + (c[2] + c[3])) + ((d[0] + d[1]) + (d[2] + d[3]));
    return rsqrtf(s * (1.0f / 1024.0f) + EPS);
}

__device__ __forceinline__ void rows_rs(const float* ss, int rowbase, int fr, int fq, float (&rs)[2][4]) {
    f32x4 v[8];
#pragma unroll
    for (int r8 = 0; r8 < 8; ++r8) v[r8] = *(const f32x4*)(ss + (size_t)(rowbase + (r8 >> 2) * 128 + (r8 & 3) * 16 + fr) * 16 + fq * 4);
    float s[8];
#pragma unroll
    for (int r8 = 0; r8 < 8; ++r8) s[r8] = (v[r8][0] + v[r8][1]) + (v[r8][2] + v[r8][3]);
#pragma unroll
    for (int r8 = 0; r8 < 8; ++r8) s[r8] += __shfl_xor(s[r8], 16);
#pragma unroll
    for (int r8 = 0; r8 < 8; ++r8) s[r8] += __shfl_xor(s[r8], 32);
#pragma unroll
    for (int r8 = 0; r8 < 8; ++r8) rs[r8 >> 2][r8 & 3] = rsqrtf(s[r8] * (1.0f / 1024.0f) + EPS);
}

using pg8::Unit;
template <int MODE> struct EpiIn {
    static constexpr bool PERM = true;
    const float* ss; bf16_t* z; bf16_t* ug;
    __device__ __forceinline__ void operator()(const f32x4 (&acc)[2][2][4][2], const Unit& u, int wr, int wc, int fr, int fq) const {
        float rsv[2][4]; rows_rs(ss, u.pm * 256 + wr * 64, fr, fq, rsv);
#pragma unroll
        for (int ai = 0; ai < 2; ++ai)
#pragma unroll
            for (int m = 0; m < 4; ++m) {
                const int row = u.pm * 256 + ai * 128 + wr * 64 + m * 16 + fr;
                const float rs = rsv[ai][m];
#pragma unroll
                for (int bj = 0; bj < 2; ++bj) {
                    const int col = u.pn * 256 + bj * 128 + wc * 32 + 8 * fq;
                    const f32x4 v0 = acc[ai][bj][m][0] * rs, v1 = acc[ai][bj][m][1] * rs;
                    u32x4 w; w.x = cvt_pk_bf16(v0[0], v0[1]); w.y = cvt_pk_bf16(v0[2], v0[3]); w.z = cvt_pk_bf16(v1[0], v1[1]); w.w = cvt_pk_bf16(v1[2], v1[3]);
                    bf16_t* p;
                    if (MODE == 0) p = z + (size_t)row * 3072 + col;
                    else if (col < 512) p = ug + ((size_t)((col >> 4) * NCHUNK + (row >> 5)) * UGP + (row & 31) * 16 + (col & 15));
                    else p = z + (size_t)row * 1536 + (col - 512);
                    *(u32x4*)p = w;
                }
            }
    }
};
__device__ __forceinline__ bf16_t* lo_row(float* outbase, int row) { return (bf16_t*)((unsigned char*)outbase + (size_t)row * 4096 + 2048); }
template <bool FP32BASE> struct EpiRes {
    static constexpr bool PERM = true;
    const float* xin; bf16_t* hi; float* outbase; float* ss;
    __device__ __forceinline__ void operator()(const f32x4 (&acc)[2][2][4][2], const Unit& u, int wr, int wc, int fr, int fq) const {
        const int rowb = u.pm * 256 + wr * 64 + fr, colb = u.pn * 256 + wc * 32 + 8 * fq;
        f32x4 b[3][4]; u32x4 hv[3][2], lv[3][2];
#define ER_LD(r8, buf) do { const int row_ = rowb + ((r8) >> 2) * 128 + ((r8) & 3) * 16; \
        if (FP32BASE) { const float* bp_ = xin + (size_t)row_ * 1024 + colb; \
            b[buf][0] = *(const f32x4*)(bp_); b[buf][1] = *(const f32x4*)(bp_ + 4); b[buf][2] = *(const f32x4*)(bp_ + 128); b[buf][3] = *(const f32x4*)(bp_ + 132); } \
        else { const bf16_t* hp_ = hi + (size_t)row_ * 1024 + colb; const bf16_t* lp_ = lo_row(outbase, row_) + colb; \
            hv[buf][0] = *(const u32x4*)(hp_); hv[buf][1] = *(const u32x4*)(hp_ + 128); if (RES_LO) { lv[buf][0] = *(const u32x4*)(lp_); lv[buf][1] = *(const u32x4*)(lp_ + 128); } } } while (0)
        ER_LD(0, 0); ER_LD(1, 1);
#pragma unroll
        for (int r8 = 0; r8 < 8; ++r8) {
            if (r8 + 2 < 8) ER_LD(r8 + 2, (r8 + 2) % 3);
            const int ai = r8 >> 2, m = r8 & 3;
            const int row = rowb + ai * 128 + m * 16;
            float s = 0.f;
#pragma unroll
            for (int bj = 0; bj < 2; ++bj) {
                float v[8];
#pragma unroll
                for (int e = 0; e < 4; ++e) {
                    if (FP32BASE) { v[e] = acc[ai][bj][m][0][e] + b[r8 % 3][bj * 2][e]; v[4 + e] = acc[ai][bj][m][1][e] + b[r8 % 3][bj * 2 + 1][e]; }
                    else {
                        const unsigned hw = hv[r8 % 3][bj][e], lw = RES_LO ? lv[r8 % 3][bj][e] : 0u;
                        const float x0 = __uint_as_float(hw << 16) + __uint_as_float(lw << 16), x1 = __uint_as_float(hw & 0xffff0000u) + __uint_as_float(lw & 0xffff0000u);
                        const int e0 = 2 * e, e1 = 2 * e + 1;
                        v[e0] = (e0 < 4 ? acc[ai][bj][m][0][e0 & 3] : acc[ai][bj][m][1][e0 & 3]) + x0;
                        v[e1] = (e1 < 4 ? acc[ai][bj][m][0][e1 & 3] : acc[ai][bj][m][1][e1 & 3]) + x1;
                    }
                }
                u32x4 wh, wl;
#pragma unroll
                for (int k = 0; k < 4; ++k) {
                    const unsigned h2 = cvt_pk_bf16(v[2 * k], v[2 * k + 1]);
                    wh[k] = h2;
                    wl[k] = cvt_pk_bf16(v[2 * k] - __uint_as_float(h2 << 16), v[2 * k + 1] - __uint_as_float(h2 & 0xffff0000u));
                    s += v[2 * k] * v[2 * k] + v[2 * k + 1] * v[2 * k + 1];
                }
                *(u32x4*)(hi + (size_t)row * 1024 + colb + bj * 128) = wh;
                if (RES_LO) *(u32x4*)(lo_row(outbase, row) + colb + bj * 128) = wl;
            }
            s += __shfl_xor(s, 16); s += __shfl_xor(s, 32);
            if (fq == 0) ss[(size_t)row * 16 + u.pn * 4 + wc] = s;
        }
#undef ER_LD
    }
};
struct EpiSwiGLU {
    static constexpr bool PERM = true;
    const float* ss; bf16_t* act;
    __device__ __forceinline__ void operator()(const f32x4 (&acc)[2][2][4][2], const Unit& u, int wr, int wc, int fr, int fq) const {
        float rsv[2][4]; rows_rs(ss, u.pm * 256 + wr * 64, fr, fq, rsv);
#pragma unroll
        for (int ai = 0; ai < 2; ++ai)
#pragma unroll
            for (int m = 0; m < 4; ++m) {
                const int row = u.pm * 256 + ai * 128 + wr * 64 + m * 16 + fr;
                const float rs = rsv[ai][m];
                const int col = u.pn * 128 + wc * 32 + 8 * fq;
                float r[8];
#pragma unroll
                for (int n = 0; n < 2; ++n)
#pragma unroll
                    for (int e = 0; e < 4; ++e) {
                        const float g = acc[ai][0][m][n][e] * rs, up = acc[ai][1][m][n][e] * rs;
                        r[n * 4 + e] = g * up * __builtin_amdgcn_rcpf(1.0f + __expf(-g));
                    }
                u32x4 w; w.x = cvt_pk_bf16(r[0], r[1]); w.y = cvt_pk_bf16(r[2], r[3]); w.z = cvt_pk_bf16(r[4], r[5]); w.w = cvt_pk_bf16(r[6], r[7]);
                *(u32x4*)(act + (size_t)row * DFF + col) = w;
            }
    }
};
struct EpiS5State {
    static constexpr bool PERM = false;
    float* sst;
    __device__ __forceinline__ void operator()(const f32x4 (&acc)[2][2][4][2], const Unit& u, int wr, int wc, int fr, int fq) const {
#pragma unroll
        for (int ai = 0; ai < 2; ++ai)
#pragma unroll
            for (int m = 0; m < 4; ++m) {
                const int row = u.pm * 256 + ai * 128 + wr * 64 + m * 16 + fr;
#pragma unroll
                for (int n = 0; n < 2; ++n) {
                    const int col = wc * 32 + n * 16 + 4 * fq;
                    *(f32x4*)(sst + (size_t)row * 128 + col) = acc[ai][0][m][n];
                }
            }
    }
};
__device__ __forceinline__ float gelu_tanh(float x) {
    const float t = 1.5957691216057308f * (x + 0.044715f * x * x * x);
    return x * __builtin_amdgcn_rcpf(1.0f + __expf(-t));
}
struct EpiS5Y {
    static constexpr bool PERM = true;
    bf16_t* yg;
    __device__ __forceinline__ void operator()(const f32x4 (&acc)[2][2][4][2], const Unit& u, int wr, int wc, int fr, int fq) const {
        const int g = u.pm >> 2;
#pragma unroll
        for (int ai = 0; ai < 2; ++ai)
#pragma unroll
            for (int m = 0; m < 4; ++m) {
                const int chunk = (u.pm & 3) * 256 + ai * 128 + wr * 64 + m * 16 + fr;
#pragma unroll
                for (int bj = 0; bj < 2; ++bj) {
                    const int col = (u.pn & 1) * 256 + bj * 128 + wc * 32 + 8 * fq;
                    const int tok = chunk * CH + (col >> 4);
                    const f32x4 a = acc[ai][bj][m][0], b = acc[ai][bj][m][1];
                    u32x4 w; w.x = cvt_pk_bf16(gelu_tanh(a[0]), gelu_tanh(a[1])); w.y = cvt_pk_bf16(gelu_tanh(a[2]), gelu_tanh(a[3]));
                    w.z = cvt_pk_bf16(gelu_tanh(b[0]), gelu_tanh(b[1])); w.w = cvt_pk_bf16(gelu_tanh(b[2]), gelu_tanh(b[3]));
                    *(u32x4*)(yg + (size_t)tok * 512 + g * 16 + (col & 15)) = w;
                }
            }
    }
};
struct EpiGLU {
    static constexpr bool PERM = true;
    const bf16_t* yg; const float* bias; bf16_t* mixed;
    __device__ __forceinline__ void operator()(const f32x4 (&acc)[2][2][4][2], const Unit& u, int wr, int wc, int fr, int fq) const {
        const int rowb = u.pm * 256 + wr * 64 + fr, colb = u.pn * 256 + wc * 32 + 8 * fq;
        f32x4 bb[2][2];
#pragma unroll
        for (int bj = 0; bj < 2; ++bj) { bb[bj][0] = *(const f32x4*)(bias + colb + bj * 128); bb[bj][1] = *(const f32x4*)(bias + colb + bj * 128 + 4); }
        u32x4 yv[3][2];
#define EG_LD(r8, buf) do { const bf16_t* yp_ = yg + (size_t)(rowb + ((r8) >> 2) * 128 + ((r8) & 3) * 16) * 512 + colb; \
        yv[buf][0] = *(const u32x4*)(yp_); yv[buf][1] = *(const u32x4*)(yp_ + 128); } while (0)
        EG_LD(0, 0); EG_LD(1, 1);
#pragma unroll
        for (int r8 = 0; r8 < 8; ++r8) {
            if (r8 + 2 < 8) EG_LD(r8 + 2, (r8 + 2) % 3);
            const int ai = r8 >> 2, m = r8 & 3;
            const int row = rowb + ai * 128 + m * 16;
#pragma unroll
            for (int bj = 0; bj < 2; ++bj) {
                float r[8], av[8];
#pragma unroll
                for (int e = 0; e < 4; ++e) { av[e] = acc[ai][bj][m][0][e] + bb[bj][0][e]; av[4 + e] = acc[ai][bj][m][1][e] + bb[bj][1][e]; }
#pragma unroll
                for (int k = 0; k < 4; ++k) {
                    const unsigned yw = yv[r8 % 3][bj][k];
                    const float y0 = __uint_as_float(yw << 16), y1 = __uint_as_float(yw & 0xffff0000u);
                    r[2 * k] = y0 * __builtin_amdgcn_rcpf(1.0f + __expf(-av[2 * k]));
                    r[2 * k + 1] = y1 * __builtin_amdgcn_rcpf(1.0f + __expf(-av[2 * k + 1]));
                }
                u32x4 w; w.x = cvt_pk_bf16(r[0], r[1]); w.y = cvt_pk_bf16(r[2], r[3]); w.z = cvt_pk_bf16(r[4], r[5]); w.w = cvt_pk_bf16(r[6], r[7]);
                *(u32x4*)(mixed + (size_t)row * 1024 + colb + bj * 128) = w;
            }
        }
#undef EG_LD
    }
};

__device__ __forceinline__ int rel_bucket(int d) {
    if (d < 16) return d < 0 ? 0 : d;
    const float scaled = logf((float)d / 16.0f) / 4.852030263919617f * 16.0f;
    const int large = 16 + (int)scaled;
    return large < 31 ? large : 31;
}
__device__ __forceinline__ void transpose_tile(const float* __restrict__ src, bf16_t* __restrict__ dst, const float* __restrict__ kscale, int K, int N, int mode,
                                               float cs, int cs_lo, int cs_hi, int tile, LAS float* t) {
    const int tid = threadIdx.x, tn = tile % (N / 64), tk = tile / (N / 64);
#pragma unroll
    for (int i = 0; i < 2; ++i) {
        const int r = (tid >> 4) + 32 * i, c4 = (tid & 15) * 4, k = tk * 64 + r;
        f32x4 v = *(const f32x4*)(src + (size_t)k * N + tn * 64 + c4);
        const float ks = kscale ? kscale[k] : 1.0f;
#pragma unroll
        for (int e = 0; e < 4; ++e) t[r * 65 + c4 + e] = v[e] * ks;
    }
    __syncthreads();
    {
        const int nl = tid >> 3, k8 = (tid & 7) * 8, n = tn * 64 + nl;
        const float sc = (n >= cs_lo && n < cs_hi) ? cs : 1.0f;
        float v[8];
#pragma unroll
        for (int e = 0; e < 8; ++e) v[e] = t[(k8 + e) * 65 + nl] * sc;
        u32x4 w; w.x = cvt_pk_bf16(v[0], v[1]); w.y = cvt_pk_bf16(v[2], v[3]); w.z = cvt_pk_bf16(v[4], v[5]); w.w = cvt_pk_bf16(v[6], v[7]);
        const int np = mode == 0 ? n : (256 * (n >> 7) + (mode == 2 ? 128 : 0) + (n & 127));
        *(u32x4*)(dst + (size_t)np * K + tk * 64 + k8) = w;
    }
    __syncthreads();
}

__device__ __forceinline__ void dsincos(double x, double& s, double& c) {
    const double k = rint(x * 0.15915494309189535);
    double r = fma(-k, 6.283185307179586, x); r = fma(-k, 2.4492935982947064e-16, r);
    const double r2 = r * r;
    double ts = r, tc = 1.0; s = r; c = 1.0;
    for (int n = 1; n <= 15; ++n) { tc *= -r2 / (double)((2 * n - 1) * (2 * n)); ts *= -r2 / (double)((2 * n) * (2 * n + 1)); c += tc; s += ts; }
}

__device__ __forceinline__ void s5_prep_unit(const Args& A, int e, int g, LAS unsigned char* lds) {
    const int tid = threadIdx.x;
    LAS float* apr = (LAS float*)lds;
    LAS float* api = apr + 33 * 64;
    LAS float* bbr = api + 33 * 64;
    LAS float* bbi = bbr + 1024;
    LAS float* ccr = bbi + 1024;
    LAS float* cci = ccr + 1024;
    LAS float* kl = cci + 1024;
    LAS float* cof = kl + 8192;
    const int eg = e * 32 + g;
    if (tid < 64) {
        const int p = tid;
        const double lr = (double)A.in[10][eg * 64 + p], li = (double)A.in[11][eg * 64 + p];
        const double dt = (double)expf(A.in[12][eg]);
        const double mag = exp(lr * dt); double sn, cs; dsincos(li * dt, sn, cs);
        const double ar = mag * cs, ai = mag * sn;
        const double nr = ar - 1.0, ni = ai, den = lr * lr + li * li;
        cof[2 * p] = (float)((nr * lr + ni * li) / den); cof[2 * p + 1] = (float)((ni * lr - nr * li) / den);
        double pr = 1.0, pi = 0.0;
        for (int l = 0; l <= 32; ++l) { apr[l * 64 + p] = (float)pr; api[l * 64 + p] = (float)pi; const double t = pr * ar - pi * ai; pi = pr * ai + pi * ar; pr = t; }
        float* al = (float*)(A.ws + WS_AL) + (size_t)eg * 128;
        al[p] = apr[32 * 64 + p]; al[64 + p] = api[32 * 64 + p];
    }
    __syncthreads();
    for (int i = tid; i < 1024; i += 512) {
        const int p = i >> 4;
        const float br = A.in[13][(size_t)eg * 1024 + i], bi = A.in[14][(size_t)eg * 1024 + i], cr = cof[2 * p], ci = cof[2 * p + 1];
        bbr[i] = cr * br - ci * bi; bbi[i] = cr * bi + ci * br;
        ccr[i] = A.in[15][(size_t)eg * 1024 + i]; cci[i] = A.in[16][(size_t)eg * 1024 + i];
    }
    __syncthreads();
    for (int i = tid; i < 8192; i += 512) {
        const int l = i >> 8, c = (i >> 4) & 15, cp = i & 15;
        float s = 0.f;
        for (int p = 0; p < 64; ++p) {
            const float wr_ = ccr[c * 64 + p] * apr[l * 64 + p] - cci[c * 64 + p] * api[l * 64 + p];
            const float wi_ = ccr[c * 64 + p] * api[l * 64 + p] + cci[c * 64 + p] * apr[l * 64 + p];
            s += wr_ * bbr[p * 16 + cp] - wi_ * bbi[p * 16 + cp];
        }
        if (l == 0 && c == cp) s += A.in[17][e * 512 + g * 16 + c];
        kl[i] = s;
    }
    __syncthreads();
    bf16_t* bty = (bf16_t*)(A.ws + WS_BTY + (size_t)e * SZ_BTY) + (size_t)g * 512 * 640;
    for (int i = tid; i < 512 * 320; i += 512) {
        const int rr = i / 320, k0 = (i % 320) * 2, ii = rr >> 4, c = rr & 15;
        float v[2];
#pragma unroll
        for (int q = 0; q < 2; ++q) {
            const int k = k0 + q;
            if (k < 512) { const int j = k >> 4, cp = k & 15; v[q] = (j <= ii) ? kl[(ii - j) * 256 + c * 16 + cp] : 0.f; }
            else { const int ri = (k - 512) >> 6, p = (k - 512) & 63; const float pr = apr[(ii + 1) * 64 + p], pi = api[(ii + 1) * 64 + p], cr = ccr[c * 64 + p], ci = cci[c * 64 + p];
                   v[q] = ri == 0 ? (cr * pr - ci * pi) : -(cr * pi + ci * pr); }
        }
        *(unsigned*)(bty + (size_t)rr * 640 + k0) = cvt_pk_bf16(v[0], v[1]);
    }
    bf16_t* btf = (bf16_t*)(A.ws + WS_BTF + (size_t)e * SZ_BTF) + (size_t)g * 256 * 512;
    for (int i = tid; i < 256 * 256; i += 512) {
        const int rr = i >> 8, k0 = (i & 255) * 2;
        float v[2] = {0.f, 0.f};
        if (rr < 128) {
            const int ri = rr >> 6, p = rr & 63;
#pragma unroll
            for (int q = 0; q < 2; ++q) {
                const int k = k0 + q, j = k >> 4, cp = k & 15;
                const float pr = apr[(31 - j) * 64 + p], pi = api[(31 - j) * 64 + p], br = bbr[p * 16 + cp], bi = bbi[p * 16 + cp];
                v[q] = ri == 0 ? (pr * br - pi * bi) : (pr * bi + pi * br);
            }
        }
        *(unsigned*)(btf + (size_t)rr * 512 + k0) = cvt_pk_bf16(v[0], v[1]);
    }
    __syncthreads();
}

struct TrDesc { const float* src; bf16_t* dst; const float* ks; int K, N, mode; float cs; int lo, hi, tile; };
__device__ __forceinline__ void tr_load(const TrDesc& d, int tid, f32x4 (&v)[2], float (&kv)[2]) {
    const int tn = d.tile % (d.N / 64), tk = d.tile / (d.N / 64);
#pragma unroll
    for (int i = 0; i < 2; ++i) {
        const int r = (tid >> 4) + 32 * i, c4 = (tid & 15) * 4, k = tk * 64 + r;
        v[i] = *(const f32x4*)(d.src + (size_t)k * d.N + tn * 64 + c4);
        kv[i] = d.ks ? d.ks[k] : 1.0f;
    }
}
__device__ __forceinline__ void tr_finish(const TrDesc& d, int tid, const f32x4 (&v)[2], const float (&kv)[2], LAS float* t) {
    const int tn = d.tile % (d.N / 64), tk = d.tile / (d.N / 64);
#pragma unroll
    for (int i = 0; i < 2; ++i) {
        const int r = (tid >> 4) + 32 * i, c4 = (tid & 15) * 4;
#pragma unroll
        for (int e = 0; e < 4; ++e) t[r * 65 + c4 + e] = v[i][e] * kv[i];
    }
    __syncthreads();
    {
        const int nl = tid >> 3, k8 = (tid & 7) * 8, n = tn * 64 + nl;
        const float sc = (n >= d.lo && n < d.hi) ? d.cs : 1.0f;
        float w8[8];
#pragma unroll
        for (int e = 0; e < 8; ++e) w8[e] = t[(k8 + e) * 65 + nl] * sc;
        u32x4 w; w.x = cvt_pk_bf16(w8[0], w8[1]); w.y = cvt_pk_bf16(w8[2], w8[3]); w.z = cvt_pk_bf16(w8[4], w8[5]); w.w = cvt_pk_bf16(w8[6], w8[7]);
        const int np = d.mode == 0 ? n : (256 * (n >> 7) + (d.mode == 2 ? 128 : 0) + (n & 127));
        *(u32x4*)(d.dst + (size_t)np * d.K + tk * 64 + k8) = w;
    }
    __syncthreads();
}
__device__ __forceinline__ void tr_tile(const TrDesc& d, int tid, LAS float* t) {
    const int tn = d.tile % (d.N / 128), tk = d.tile / (d.N / 128);
    f32x4 v[8]; float kv[8];
#pragma unroll
    for (int i = 0; i < 8; ++i) {
        const int idx = tid + 512 * i, r = idx >> 5, c4 = (idx & 31) * 4, k = tk * 128 + r;
        v[i] = *(const f32x4*)(d.src + (size_t)k * d.N + tn * 128 + c4);
        kv[i] = d.ks ? d.ks[k] : 1.0f;
    }
#pragma unroll
    for (int i = 0; i < 8; ++i) {
        const int idx = tid + 512 * i, r = idx >> 5, c4 = (idx & 31) * 4;
        *(LAS f32x4*)(t + r * 132 + c4) = v[i] * kv[i];
    }
    __syncthreads();
#pragma unroll
    for (int j = 0; j < 4; ++j) {
        const int pidx = tid + 512 * j, nl = pidx & 127, k8 = (pidx >> 7) * 8, n = tn * 128 + nl;
        const float sc = (n >= d.lo && n < d.hi) ? d.cs : 1.0f;
        float w8[8];
#pragma unroll
        for (int e = 0; e < 8; ++e) w8[e] = t[(k8 + e) * 132 + nl] * sc;
        u32x4 w; w.x = cvt_pk_bf16(w8[0], w8[1]); w.y = cvt_pk_bf16(w8[2], w8[3]); w.z = cvt_pk_bf16(w8[4], w8[5]); w.w = cvt_pk_bf16(w8[6], w8[7]);
        const int np = d.mode == 0 ? n : (256 * (n >> 7) + (d.mode == 2 ? 128 : 0) + (n & 127));
        *(u32x4*)(d.dst + (size_t)np * d.K + tk * 128 + k8) = w;
    }
    __syncthreads();
}
__device__ __forceinline__ void tr_decode(const Args& A, int it, TrDesc& d) {
    unsigned char* ws = A.ws;
    constexpr int T_GU = (1024 / 128) * (2816 / 128), T_DN = T_GU, T_EIN = 8 * 16, T_SQ = 64, T_GLU = 16, T_OIN = 8 * 24;
    constexpr int PER_L = 2 * T_GU + T_DN, PER_E = T_EIN + T_SQ + T_GLU + T_OIN + T_SQ;
    d.ks = nullptr; d.mode = 0; d.cs = 1.f; d.lo = 0; d.hi = 0;
    if (it < 4 * PER_L) {
        const int l = it / PER_L; int r = it % PER_L;
        if (r < 2 * T_GU) { const int up = r >= T_GU; if (up) r -= T_GU;
            d.src = A.in[up ? 6 : 5] + (size_t)l * 1024 * 2816; d.dst = (bf16_t*)(ws + WS_GU + l * SZ_GU); d.ks = A.in[3] + l * 1024; d.K = 1024; d.N = 2816; d.mode = up ? 2 : 1; d.tile = r; }
        else { r -= 2 * T_GU; d.src = A.in[7] + (size_t)l * 2816 * 1024; d.dst = (bf16_t*)(ws + WS_DN + l * SZ_DN); d.K = 2816; d.N = 1024; d.tile = r; }
    } else {
        it -= 4 * PER_L; const int l = it / PER_E; int r = it % PER_E;
        if (r < T_EIN) { d.src = A.in[8] + (size_t)l * 1024 * 2048; d.dst = (bf16_t*)(ws + WS_EIN + l * SZ_EIN); d.ks = A.in[2] + (2 * l) * 1024; d.K = 1024; d.N = 2048; d.cs = QSC; d.lo = 512; d.hi = 1024; d.tile = r; return; } r -= T_EIN;
        if (r < T_SQ) { d.src = A.in[9] + (size_t)l * 1024 * 1024; d.dst = (bf16_t*)(ws + WS_EOUT + l * SZ_SQ); d.K = 1024; d.N = 1024; d.tile = r; return; } r -= T_SQ;
        if (r < T_GLU) { d.src = A.in[18] + (size_t)l * 512 * 512; d.dst = (bf16_t*)(ws + WS_GLU + l * SZ_GLU); d.K = 512; d.N = 512; d.tile = r; return; } r -= T_GLU;
        if (r < T_OIN) { d.src = A.in[20] + (size_t)l * 1024 * 3072; d.dst = (bf16_t*)(ws + WS_OIN + l * SZ_OIN); d.ks = A.in[2] + (2 * l + 1) * 1024; d.K = 1024; d.N = 3072; d.cs = QSC; d.lo = 0; d.hi = 1024; d.tile = r; return; } r -= T_OIN;
        d.src = A.in[21] + (size_t)l * 1024 * 1024; d.dst = (bf16_t*)(ws + WS_OOUT + l * SZ_SQ); d.K = 1024; d.N = 1024; d.tile = r;
    }
}

__device__ __forceinline__ void prep_phase(const Args& A, LAS unsigned char* lds, int G, int c) {
    int tid_ = threadIdx.x; asm volatile("" : "+v"(tid_));
    const int tid = tid_, lane = tid & 63, wid = tid >> 6;
    unsigned char* ws = A.ws;
    constexpr int T_GU = (1024 / 128) * (2816 / 128), T_DN = T_GU, T_EIN = 8 * 16, T_SQ = 64, T_GLU = 16, T_OIN = 8 * 24;
    constexpr int N_TR = 4 * (2 * T_GU + T_DN) + 2 * (T_EIN + T_SQ + T_GLU + T_OIN + T_SQ);
    constexpr int N_XB = NT / 8;
    for (int it = c; it < 65; it += G) {
        if (it < 64) { s5_prep_unit(A, it >> 5, it & 31, lds); continue; }
        float* lut = (float*)(ws + WS_LUTD);
        for (int i = tid; i < 8 * 2176; i += 512) { const int h = i / 2176, d = i % 2176 - 128; lut[i] = d < 0 ? -1e30f : A.in[1][rel_bucket(d) * 16 + 8 + h] * LOG2E; }
        {
            float* m = (float*)(ws + WS_MISC);
            m[256 + tid] = A.in[1][tid];
            m[1024 + tid] = A.in[4][tid]; m[1536 + tid] = A.in[4][512 + tid];
            m[2048 + tid] = A.in[19][tid]; m[2560 + tid] = A.in[19][512 + tid];
            if (tid < 256) m[3072 + tid] = A.in[26][tid];
        }
        if (wid < 2) {
            const int o = wid;
            float a = A.in[22][o * 64 + lane] * A.in[23][o * 64 + lane], b = A.in[24][o * 64 + lane] * A.in[25][o * 64 + lane];
            a = wave_sum(a); b = wave_sum(b);
            const float lam_init = 0.8f - 0.6f * expf(-0.3f * (float)(2 * o + 1));
            if (lane == 0) { float* m = (float*)(ws + WS_MISC); m[o * 2] = expf(a) - expf(b) + lam_init; m[o * 2 + 1] = 1.0f - lam_init; }
        }
    }
    __syncthreads();
    {
        LAS float* t = (LAS float*)lds;
        if (G == 256) { if (c >= 65) for (int it = c - 65; it < N_TR; it += G - 65) { TrDesc d0; tr_decode(A, it, d0); tr_tile(d0, tid, t); } }
        else for (int it = c; it < N_TR; it += G) { TrDesc d0; tr_decode(A, it, d0); tr_tile(d0, tid, t); }
    }
    for (int it = (G == 256 ? (c >= 65 ? c - 65 : N_XB) : c); it < N_XB; it += (G == 256 ? G - 65 : G)) {
        const int row = it * 8 + wid;
        const float* xr = A.in[0] + (size_t)row * 1024;
        bf16_t* xo = (bf16_t*)(ws + WS_XB) + (size_t)row * 1024;
        float s = 0.f;
#pragma unroll
        for (int i = 0; i < 4; ++i) {
            const f32x4 v = *(const f32x4*)(xr + i * 256 + lane * 4);
            s += (v[0] * v[0] + v[1] * v[1]) + (v[2] * v[2] + v[3] * v[3]);
            u32x2 w; w.x = cvt_pk_bf16(v[0], v[1]); w.y = cvt_pk_bf16(v[2], v[3]);
            *(u32x2*)(xo + i * 256 + lane * 4) = w;
        }
        s = wave_sum(s);
        if (lane < 16) ((float*)(ws + WS_SS))[(size_t)row * 16 + lane] = lane == 0 ? s : 0.f;
    }
}

constexpr int DA_KP = 144, DA_VP = 320, DA_K2 = 64 * DA_KP, DA_KST = 2 * DA_K2, DA_VST = 64 * DA_VP, DA_VOFF = 2 * DA_KST, DA_LUT = DA_VOFF + 3 * DA_VST, DA_Q = DA_LUT + 8704;
static_assert(DA_Q + 32768 <= LDS_BARW && 128 * 132 * 4 <= DA_LUT, "diff attention LDS map");
constexpr float DA_THR = 6.0f;
__device__ __forceinline__ s16x4 tr_read(LAS const unsigned char* p) {
    typedef short v4i16_t __attribute__((ext_vector_type(4)));
    return __builtin_bit_cast(s16x4, __builtin_amdgcn_ds_read_tr16_b64_v4i16((LAS v4i16_t*)p));
}
__device__ __forceinline__ void da_kload(bf16x8 (&kf)[8], LAS const unsigned char* kb) {
#pragma unroll
    for (int d = 0; d < 4; ++d) { kf[2 * d] = *(LAS const bf16x8*)(kb + d * 32); kf[2 * d + 1] = *(LAS const bf16x8*)(kb + 32 * DA_KP + d * 32); }
}
__device__ __forceinline__ void da_qk(f32x16& s0, f32x16& s1, const bf16x8 (&kf)[8], LAS const unsigned char* qb, LAS const float* lut, int qpos, int qrow0, int kt, int hh) {
    const int dmin = qrow0 - (kt * 64 + 63);
    if (dmin >= 1513) {
#pragma unroll
        for (int r = 0; r < 16; ++r) { s0[r] = 0.f; s1[r] = 0.f; }
    } else {
        LAS const float* lp = lut + (128 - 59 + qpos - kt * 64 - 4 * hh);
#pragma unroll
        for (int r = 0; r < 16; ++r) { const int cr = (r & 3) + 8 * (r >> 2); s0[r] = lp[59 - cr]; s1[r] = lp[27 - cr]; }
    }
#pragma unroll
    for (int d = 0; d < 4; ++d) {
        const bf16x8 q = *(LAS const bf16x8*)(qb + d * 1024);
        s0 = __builtin_amdgcn_mfma_f32_32x32x16_bf16(kf[2 * d], q, s0, 0, 0, 0);
        s1 = __builtin_amdgcn_mfma_f32_32x32x16_bf16(kf[2 * d + 1], q, s1, 0, 0, 0);
    }
}
__device__ __forceinline__ void da_pv(f32x16 (&oacc)[4], LAS const unsigned char* vb, const bf16x8 (&pf)[4]) {
#pragma unroll
    for (int sk = 0; sk < 4; ++sk) {
#pragma unroll
        for (int dv = 0; dv < 4; ++dv) {
            const s16x4 lo = tr_read(vb + (16 * sk) * DA_VP + dv * 64), hi = tr_read(vb + (16 * sk + 8) * DA_VP + dv * 64);
            const bf16x8 vf = (bf16x8){lo[0], lo[1], lo[2], lo[3], hi[0], hi[1], hi[2], hi[3]};
            oacc[dv] = __builtin_amdgcn_mfma_f32_32x32x16_bf16(vf, pf[sk], oacc[dv], 0, 0, 0);
        }
        __builtin_amdgcn_sched_barrier(0);
    }
}
__device__ __forceinline__ float max3f(float a, float b, float c) { return fmaxf(fmaxf(a, b), c); }
__device__ __forceinline__ void da_smax(f32x16& s0, f32x16& s1, LAS const float* lut, float bfar, int qpos, int qrow0, int kt, int hh,
                                        float& mref, float& lrun, f32x16 (&oacc)[4], bf16x8 (&pfp)[4], float& moff) {
    const float badd = (qrow0 - (kt * 64 + 63) >= 1513) ? bfar : 0.f;
    float ma = max3f(s0[0], s0[1], s0[2]), mb = max3f(s1[0], s1[1], s1[2]);
    ma = max3f(ma, s0[3], s0[4]); mb = max3f(mb, s1[3], s1[4]);
    ma = max3f(ma, s0[5], s0[6]); mb = max3f(mb, s1[5], s1[6]);
    ma = max3f(ma, s0[7], s0[8]); mb = max3f(mb, s1[7], s1[8]);
    ma = max3f(ma, s0[9], s0[10]); mb = max3f(mb, s1[9], s1[10]);
    ma = max3f(ma, s0[11], s0[12]); mb = max3f(mb, s1[11], s1[12]);
    ma = max3f(ma, s0[13], s0[14]); mb = max3f(mb, s1[13], s1[14]);
    float mx = max3f(ma, mb, fmaxf(s0[15], s1[15]));
    mx = fmaxf(mx, __shfl_xor(mx, 32)) + badd;
    if (__builtin_amdgcn_ballot_w64(mx > mref + DA_THR) != 0ull) {
        const float mnew = fmaxf(mref, mx), alpha = __builtin_amdgcn_exp2f(mref - mnew);
        mref = mnew; lrun *= alpha;
#pragma unroll
        for (int i = 0; i < 4; ++i)
#pragma unroll
            for (int r = 0; r < 16; ++r) oacc[i][r] *= alpha;
#pragma unroll
        for (int i = 0; i < 4; ++i) {
            u32x4 w = __builtin_bit_cast(u32x4, pfp[i]);
#pragma unroll
            for (int k = 0; k < 4; ++k) w[k] = cvt_pk_bf16(__uint_as_float(w[k] << 16) * alpha, __uint_as_float(w[k] & 0xffff0000u) * alpha);
            pfp[i] = __builtin_bit_cast(bf16x8, w);
        }
    }
    moff = mref - badd;
}
__device__ __forceinline__ void da_exp(f32x16& s0, f32x16& s1, float moff, float& lrun) {
    float pa = 0.f, pb = 0.f;
#pragma unroll
    for (int r = 0; r < 16; ++r) { s0[r] = __builtin_amdgcn_exp2f(s0[r] - moff); s1[r] = __builtin_amdgcn_exp2f(s1[r] - moff); pa += s0[r]; pb += s1[r]; }
    lrun += pa + pb;
}
__device__ __forceinline__ void da_pack(const f32x16& s0, const f32x16& s1, bf16x8 (&pf)[4]) {
#pragma unroll
    for (int k2 = 0; k2 < 2; ++k2) {
        u32x4 w0, w1;
        w0.x = cvt_pk_bf16(s0[8 * k2 + 0], s0[8 * k2 + 1]); w0.y = cvt_pk_bf16(s0[8 * k2 + 2], s0[8 * k2 + 3]); w0.z = cvt_pk_bf16(s0[8 * k2 + 4], s0[8 * k2 + 5]); w0.w = cvt_pk_bf16(s0[8 * k2 + 6], s0[8 * k2 + 7]);
        w1.x = cvt_pk_bf16(s1[8 * k2 + 0], s1[8 * k2 + 1]); w1.y = cvt_pk_bf16(s1[8 * k2 + 2], s1[8 * k2 + 3]); w1.z = cvt_pk_bf16(s1[8 * k2 + 4], s1[8 * k2 + 5]); w1.w = cvt_pk_bf16(s1[8 * k2 + 6], s1[8 * k2 + 7]);
        pf[k2] = __builtin_bit_cast(bf16x8, w0); pf[2 + k2] = __builtin_bit_cast(bf16x8, w1);
    }
}
#define DA_TR2(lo, hi, base, o1, o2) asm volatile("ds_read_b64_tr_b16 %0, %2 offset:%c3\n\tds_read_b64_tr_b16 %1, %2 offset:%c4" : "=&v"(lo), "=&v"(hi) : "v"(base), "i"(o1), "i"(o2) : "memory")
template <bool DO_EXP>
__device__ __forceinline__ void da_pvexp(f32x16 (&oacc)[4], unsigned vb, const bf16x8 (&pf)[4], f32x16& s0, f32x16& s1, float moff, float& lrun) {
    s16x4 lo[2][4], hi[2][4];
    float pa = 0.f, pb = 0.f;
#pragma unroll
    for (int dv = 0; dv < 4; ++dv) DA_TR2(lo[0][dv], hi[0][dv], vb, dv * 64, 8 * DA_VP + dv * 64);
#pragma unroll
    for (int g = 0; g < 4; ++g) {
        if (DO_EXP) {
#pragma unroll
            for (int r = 4 * g; r < 4 * g + 4; ++r) { s0[r] = __builtin_amdgcn_exp2f(s0[r] - moff); s1[r] = __builtin_amdgcn_exp2f(s1[r] - moff); pa += s0[r]; pb += s1[r]; }
        }
        if (g < 3) {
#pragma unroll
            for (int dv = 0; dv < 4; ++dv) DA_TR2(lo[(g + 1) & 1][dv], hi[(g + 1) & 1][dv], vb, (16 * (g + 1)) * DA_VP + dv * 64, (16 * (g + 1) + 8) * DA_VP + dv * 64);
            asm volatile("s_waitcnt lgkmcnt(8)" ::: "memory");
        } else asm volatile("s_waitcnt lgkmcnt(0)" ::: "memory");
        __builtin_amdgcn_sched_barrier(0);
#pragma unroll
        for (int dv = 0; dv < 4; ++dv) {
            const s16x4 l = lo[g & 1][dv], h = hi[g & 1][dv];
            const bf16x8 vf = (bf16x8){l[0], l[1], l[2], l[3], h[0], h[1], h[2], h[3]};
            oacc[dv] = __builtin_amdgcn_mfma_f32_32x32x16_bf16(vf, pf[g], oacc[dv], 0, 0, 0);
        }
        __builtin_amdgcn_sched_barrier(0);
    }
    lrun += pa + pb;
}
__device__ __forceinline__ void diff_attn_phase(const Args& A, LAS unsigned char* lds, int o, int G, int c) {
    int tid_ = threadIdx.x; asm volatile("" : "+v"(tid_));
    const int wid = __builtin_amdgcn_readfirstlane(tid_ >> 6);
    const int st = wid >> 2, qt = wid & 3;
    const bf16_t* z = (const bf16_t*)(A.ws + WS_Z);
    bf16_t* mixed = (bf16_t*)(A.ws + WS_MIXED);
    const float* lutg = (const float*)(A.ws + WS_LUTD);
    const float lam = ((const float*)(A.ws + WS_MISC))[o * 2], oscale = ((const float*)(A.ws + WS_MISC))[o * 2 + 1];
    const float* subg = (const float*)(A.ws + WS_MISC) + 3072 + o * 128;
    LAS float* lut = (LAS float*)(lds + DA_LUT);
    LAS float* exch = (LAS float*)lds;
    constexpr int NUNITS = NB * 8 * 64;
    for (int ui = c; ui < NUNITS; ui += G) {
        int tid_u = tid_; asm volatile("" : "+v"(tid_u));
        const int tid = tid_u, lane = tid & 63, qi = lane & 31, hh = lane >> 5;
        const int round = ui / 256, cc = ui % 256;
        int qb, bh;
        if (G == 256) {
            const int x = cc & 7, j = cc >> 3; bh = (round >> 1) * 8 + x; qb = (round & 1) ? j : 63 - j; }
        else { qb = 63 - (ui >> 5); bh = ui & 31; }
        const int b = bh >> 3, h = bh & 7;
        const int nt = 2 * (qb + 1);
        const size_t tok0 = (size_t)b * SEQ;
        for (int i = tid; i < 544; i += 512) *(LAS f32x4*)(lut + i * 4) = *(const f32x4*)(lutg + h * 2176 + i * 4);
        LAS unsigned char* qfl = lds + DA_Q + wid * 4096 + lane * 16;
        {
            const bf16_t* qp = z + (tok0 + qb * 128 + qt * 32 + qi) * 3072 + h * 128 + st * 64 + hh * 8;
#pragma unroll
            for (int d = 0; d < 4; ++d) *(LAS bf16x8*)(qfl + d * 1024) = *(const bf16x8*)(qp + d * 16);
        }
        const int kr = tid >> 3, kc = tid & 7;
        const bf16_t* kp1 = z + (tok0 + kr) * 3072 + 1024 + h * 128 + kc * 8;
        const int vr0 = tid >> 4, vc = tid & 15;
        const bf16_t* vp = z + (tok0 + vr0) * 3072 + 2048 + h * 128 + vc * 8;
        const unsigned kwo = kr * DA_KP + kc * 16, vwo = vr0 * DA_VP + vc * 16;
        constexpr size_t TS = (size_t)64 * 3072;
        u32x4 rk1, rk2, rv0, rv1, bk1, bk2, bv0, bv1;
#define DA_LDK(t) do { rk1 = *(const u32x4*)(kp1 + (size_t)(t) * TS); rk2 = *(const u32x4*)(kp1 + (size_t)(t) * TS + 64); } while (0)
#define DA_LDV(t) do { rv0 = *(const u32x4*)(vp + (size_t)(t) * TS); rv1 = *(const u32x4*)(vp + (size_t)(t) * TS + (size_t)32 * 3072); } while (0)
#define DA_LDKB(t) do { bk1 = *(const u32x4*)(kp1 + (size_t)(t) * TS); bk2 = *(const u32x4*)(kp1 + (size_t)(t) * TS + 64); } while (0)
#define DA_LDVB(t) do { bv0 = *(const u32x4*)(vp + (size_t)(t) * TS); bv1 = *(const u32x4*)(vp + (size_t)(t) * TS + (size_t)32 * 3072); } while (0)
#define DA_STK(t) do { LAS unsigned char* sw_ = lds + ((t) & 1) * DA_KST; *(LAS u32x4*)(sw_ + kwo) = rk1; *(LAS u32x4*)(sw_ + DA_K2 + kwo) = rk2; } while (0)
#define DA_STV(t) do { LAS unsigned char* sw_ = lds + DA_VOFF + ((t) % 3) * DA_VST; *(LAS u32x4*)(sw_ + vwo) = rv0; *(LAS u32x4*)(sw_ + 32 * DA_VP + vwo) = rv1; } while (0)
        DA_LDK(0); DA_LDV(0); DA_STK(0); DA_STV(0);
        DA_LDK(1); DA_STK(1);
        __syncthreads();
        f32x16 oacc[4];
#pragma unroll
        for (int i = 0; i < 4; ++i)
#pragma unroll
            for (int r = 0; r < 16; ++r) oacc[i][r] = 0.f;
        float mref = -1e30f, lrun = 0.f, moff;
        const int qrow0 = qb * 128 + qt * 32, qpos = qrow0 + qi;
        const float bfar = lut[2175];
        const unsigned kro = st * DA_K2 + qi * DA_KP + hh * 16;
        const unsigned vro = DA_VOFF + (4 * hh + ((lane & 15) >> 2)) * DA_VP + (16 * ((lane >> 4) & 1) + 4 * (lane & 3)) * 2;
        f32x16 s0, s1;
        bf16x8 pfp[4];
#pragma unroll
        for (int i = 0; i < 4; ++i) pfp[i] = (bf16x8){0, 0, 0, 0, 0, 0, 0, 0};
        bf16x8 kf[8];
        da_kload(kf, lds + kro);
        da_qk(s0, s1, kf, qfl, lut, qpos, qrow0, 0, hh);
        __syncthreads();
        if (nt > 2) DA_LDK(2);
        DA_LDV(1);
        if (nt > 3) DA_LDKB(3);
        if (nt > 2) DA_LDVB(2);
        da_smax(s0, s1, lut, bfar, qpos, qrow0, 0, hh, mref, lrun, oacc, pfp, moff);
        da_exp(s0, s1, moff, lrun);
        da_pack(s0, s1, pfp);
        da_kload(kf, lds + DA_KST + kro);
        da_qk(s0, s1, kf, qfl, lut, qpos, qrow0, 1, hh);
        if (nt > 2) DA_STK(2);
        DA_STV(1);
        __syncthreads();
        rk1 = bk1; rk2 = bk2; rv0 = bv0; rv1 = bv1;
        for (int kt = 1; kt < nt; ++kt) {
            if (kt + 3 < nt) DA_LDKB(kt + 3);
            if (kt + 2 < nt) DA_LDVB(kt + 2);
            const int tn = kt + 1 < nt ? kt + 1 : nt - 1;
            da_kload(kf, lds + (tn & 1) * DA_KST + kro);
            __builtin_amdgcn_sched_barrier(0);
            da_smax(s0, s1, lut, bfar, qpos, qrow0, kt, hh, mref, lrun, oacc, pfp, moff);
            da_pvexp<true>(oacc, (unsigned)(size_t)(lds + vro + ((kt - 1) % 3) * DA_VST), pfp, s0, s1, moff, lrun);
            da_pack(s0, s1, pfp);
            da_qk(s0, s1, kf, qfl, lut, qpos, qrow0, tn, hh);
            if (kt + 2 < nt) DA_STK(kt + 2);
            if (kt + 1 < nt) DA_STV(kt + 1);
            __syncthreads();
            rk1 = bk1; rk2 = bk2; rv0 = bv0; rv1 = bv1;
        }
        da_pvexp<false>(oacc, (unsigned)(size_t)(lds + vro + ((nt - 1) % 3) * DA_VST), pfp, s0, s1, moff, lrun);
#undef DA_LDK
#undef DA_LDKB
#undef DA_LDVB
#undef DA_LDV
#undef DA_STK
#undef DA_STV
        __syncthreads();
        const float ltot = lrun + __shfl_xor(lrun, 32);
        const float inv = 1.0f / ltot;
        const int ql = qt * 32 + qi;
        if (st == 1) {
            const float f = inv * lam;
#pragma unroll
            for (int dv = 0; dv < 4; ++dv)
#pragma unroll
                for (int i = 0; i < 4; ++i) {
                    f32x4 v; v[0] = oacc[dv][4 * i] * f; v[1] = oacc[dv][4 * i + 1] * f; v[2] = oacc[dv][4 * i + 2] * f; v[3] = oacc[dv][4 * i + 3] * f;
                    *(LAS f32x4*)(exch + ql * 132 + dv * 32 + 8 * i + 4 * hh) = v;
                }
        }
        __syncthreads();
        if (st == 0) {
            float ssq = 0.f;
#pragma unroll
            for (int dv = 0; dv < 4; ++dv)
#pragma unroll
                for (int i = 0; i < 4; ++i) {
                    const f32x4 e = *(LAS const f32x4*)(exch + ql * 132 + dv * 32 + 8 * i + 4 * hh);
#pragma unroll
                    for (int j = 0; j < 4; ++j) { const float a = oacc[dv][4 * i + j] * inv - e[j]; oacc[dv][4 * i + j] = a; ssq += a * a; }
                }
            ssq += __shfl_xor(ssq, 32);
            const float rn = rsqrtf(ssq * (1.0f / 128.0f) + EPS) * oscale;
            bf16_t* op = mixed + (tok0 + qb * 128 + ql) * 1024 + h * 128;
#pragma unroll
            for (int dv = 0; dv < 4; ++dv)
#pragma unroll
                for (int i = 0; i < 4; ++i) {
                    const int d = dv * 32 + 8 * i + 4 * hh;
                    const f32x4 gg = *(const f32x4*)(subg + d);
                    u32x2 w; w.x = cvt_pk_bf16(oacc[dv][4 * i] * rn * gg[0], oacc[dv][4 * i + 1] * rn * gg[1]); w.y = cvt_pk_bf16(oacc[dv][4 * i + 2] * rn * gg[2], oacc[dv][4 * i + 3] * rn * gg[3]);
                    *(u32x2*)(op + d) = w;
                }
        }
        __syncthreads();
    }
}

__device__ __forceinline__ bf16_t* dilp_row(const Args& A, int pat, size_t t) {
    return pat < 2 ? (bf16_t*)((unsigned char*)A.out + t * 4096 + pat * 1024) : (bf16_t*)(A.ws + WS_XB + (size_t)NT * 2048) + t * 512;
}
__device__ __forceinline__ float* lse_base(const Args& A) { return (float*)(A.ws + WS_XB + (size_t)NT * 2048 + (size_t)NT * 1024); }
constexpr int DL_KP = 144, DL_VP = 192, DL_V = 384 * DL_KP, DL_LUT = DL_V + 384 * DL_VP;
static_assert(DL_LUT + 1024 <= LDS_BARW, "dilated LDS map");
__device__ __forceinline__ void dilated_phase(const Args& A, LAS unsigned char* lds, int G, int c) {
    int tid_ = threadIdx.x; asm volatile("" : "+v"(tid_));
    const int tid = tid_, lane = tid & 63, wid = __builtin_amdgcn_readfirstlane(tid >> 6);
    const int qi = lane & 31, hh = lane >> 5, bsel = wid >> 2, qt = wid & 3;
    const bf16_t* qkv = (const bf16_t*)(A.ws + WS_Z + ZO_QKV);
    float* lse = lse_base(A);
    LAS float* dlut = (LAS float*)(lds + DL_LUT);
    constexpr int NUNITS = 3 * NB * 8 * 32;
    int u_lo, u_hi;
    if (G == 256) {
        if (c < 128) { u_lo = c * 11; u_hi = u_lo + 11; } else { u_lo = 128 * 11 + (c - 128) * 13; u_hi = u_lo + 13; }
    } else { const int per = (NUNITS + G - 1) / G; u_lo = c * per; u_hi = (u_lo + per) < NUNITS ? (u_lo + per) : NUNITS; }
    u32x4 pk[6], pv[6];
#define DL_PRELOAD(UI) do { const int bp_ = (UI) & 31, h_ = ((UI) >> 5) & 7, b_ = ((UI) >> 8) & 3, pat_ = (UI) >> 10; \
        const int r_ = pat_ == 0 ? 1 : (pat_ == 1 ? 4 : 16), nbp_ = 32 / r_, rho_ = bp_ / nbp_, n0_ = 2 * (bp_ % nbp_); const size_t tok0_ = (size_t)b_ * SEQ; \
        _Pragma("unroll") for (int i = 0; i < 6; ++i) { const int idx = tid + 512 * i, row = idx >> 3, ch = idx & 7; int ip = row; if (n0_ == 0 && ip < 128) ip += 128; \
            const size_t tk = tok0_ + (size_t)((128 * (n0_ - 1) + ip) * r_ + rho_); \
            pk[i] = *(const u32x4*)(qkv + tk * 1536 + 512 + h_ * 64 + ch * 8); pv[i] = *(const u32x4*)(qkv + tk * 1536 + 1024 + h_ * 64 + ch * 8); } } while (0)
    if (u_lo < u_hi) DL_PRELOAD(u_lo);
    for (int ui = u_lo; ui < u_hi; ++ui) {
        const int bp = ui & 31, h = (ui >> 5) & 7, b = (ui >> 8) & 3, pat = ui >> 10;
        const int r = pat == 0 ? 1 : (pat == 1 ? 4 : 16);
        const int nbp = 32 / r, rho = bp / nbp, n0 = 2 * (bp % nbp);
        const size_t tok0 = (size_t)b * SEQ;
        if (tid < 256) { const int st_ = tid - 64; dlut[tid] = (st_ >= 0 && st_ <= 128) ? ((const float*)(A.ws + WS_MISC))[256 + rel_bucket(st_ * r) * 16 + h] * LOG2E : -1e30f; }
#pragma unroll
        for (int i = 0; i < 6; ++i) {
            const int idx = tid + 512 * i, row = idx >> 3, ch = idx & 7;
            *(LAS u32x4*)(lds + row * DL_KP + ch * 16) = pk[i];
            *(LAS u32x4*)(lds + DL_V + row * DL_VP + ch * 16) = pv[i];
        }
        const int n = n0 + bsel;
        const int iq = 32 * qt + qi;
        const size_t tq = tok0 + (size_t)((128 * n + iq) * r + rho);
        bf16x8 qf[4];
#pragma unroll
        for (int d = 0; d < 4; ++d) qf[d] = *(const bf16x8*)(qkv + tq * 1536 + h * 64 + d * 16 + hh * 8);
        __syncthreads();
        if (ui + 1 < u_hi) DL_PRELOAD(ui + 1);
        const int jb = 128 * bsel + 32 * qt;
        LAS const float* lp = dlut + (64 + 128 - 155 + qi - 4 * hh);
        LAS const unsigned char* kb = lds + (jb + qi) * DL_KP + hh * 16;
        f32x16 sc[5];
#pragma unroll
        for (int t = 0; t < 5; ++t) {
            f32x16 acc;
#pragma unroll
            for (int rr = 0; rr < 16; ++rr) acc[rr] = lp[155 - 32 * t - ((rr & 3) + 8 * (rr >> 2))];
#pragma unroll
            for (int d = 0; d < 4; ++d) acc = __builtin_amdgcn_mfma_f32_32x32x16_bf16(*(LAS const bf16x8*)(kb + (32 * t) * DL_KP + d * 32), qf[d], acc, 0, 0, 0);
            if (n == 0) {
#pragma unroll
                for (int rr = 0; rr < 16; ++rr) { const int ip = 32 * qt + 32 * t + (rr & 3) + 8 * (rr >> 2) + 4 * hh; if (ip < 128) acc[rr] = -1e30f; }
            }
            sc[t] = acc;
        }
        float mx = -1e30f;
#pragma unroll
        for (int t = 0; t < 5; ++t)
#pragma unroll
            for (int rr = 0; rr < 16; ++rr) mx = fmaxf(mx, sc[t][rr]);
        mx = fmaxf(mx, __shfl_xor(mx, 32));
        float ps = 0.f;
#pragma unroll
        for (int t = 0; t < 5; ++t)
#pragma unroll
            for (int rr = 0; rr < 16; ++rr) { sc[t][rr] = __builtin_amdgcn_exp2f(sc[t][rr] - mx); ps += sc[t][rr]; }
        ps += __shfl_xor(ps, 32);
        f32x16 oacc[2];
#pragma unroll
        for (int i = 0; i < 2; ++i)
#pragma unroll
            for (int rr = 0; rr < 16; ++rr) oacc[i][rr] = 0.f;
        const unsigned vb = (unsigned)(size_t)(lds + DL_V + (jb + 4 * hh + ((lane & 15) >> 2)) * DL_VP + (16 * ((lane >> 4) & 1) + 4 * (lane & 3)) * 2);
#pragma unroll
        for (int t = 0; t < 5; ++t) {
            s16x4 lo[4], hi[4];
#pragma unroll
            for (int s2 = 0; s2 < 2; ++s2)
#pragma unroll
                for (int dvt = 0; dvt < 2; ++dvt) DA_TR2(lo[s2 * 2 + dvt], hi[s2 * 2 + dvt], vb, (32 * t + 16 * s2) * DL_VP + dvt * 64, (32 * t + 16 * s2 + 8) * DL_VP + dvt * 64);
            bf16x8 pf[2];
#pragma unroll
            for (int s2 = 0; s2 < 2; ++s2) {
                u32x4 w; w.x = cvt_pk_bf16(sc[t][8 * s2 + 0], sc[t][8 * s2 + 1]); w.y = cvt_pk_bf16(sc[t][8 * s2 + 2], sc[t][8 * s2 + 3]);
                w.z = cvt_pk_bf16(sc[t][8 * s2 + 4], sc[t][8 * s2 + 5]); w.w = cvt_pk_bf16(sc[t][8 * s2 + 6], sc[t][8 * s2 + 7]);
                pf[s2] = __builtin_bit_cast(bf16x8, w);
            }
            asm volatile("s_waitcnt lgkmcnt(0)" ::: "memory");
            __builtin_amdgcn_sched_barrier(0);
#pragma unroll
            for (int s2 = 0; s2 < 2; ++s2)
#pragma unroll
                for (int dvt = 0; dvt < 2; ++dvt) {
                    const s16x4 l = lo[s2 * 2 + dvt], hv = hi[s2 * 2 + dvt];
                    const bf16x8 vf = (bf16x8){l[0], l[1], l[2], l[3], hv[0], hv[1], hv[2], hv[3]};
                    oacc[dvt] = __builtin_amdgcn_mfma_f32_32x32x16_bf16(vf, pf[s2], oacc[dvt], 0, 0, 0);
                }
            __builtin_amdgcn_sched_barrier(0);
        }
        const float inv = 1.0f / ps;
        bf16_t* op = dilp_row(A, pat, tq) + h * 64;
#pragma unroll
        for (int dvt = 0; dvt < 2; ++dvt)
#pragma unroll
            for (int i = 0; i < 4; ++i) {
                u32x2 w; w.x = cvt_pk_bf16(oacc[dvt][4 * i] * inv, oacc[dvt][4 * i + 1] * inv); w.y = cvt_pk_bf16(oacc[dvt][4 * i + 2] * inv, oacc[dvt][4 * i + 3] * inv);
                *(u32x2*)(op + dvt * 32 + 8 * i + 4 * hh) = w;
            }
        if (hh == 0) lse[((size_t)pat * NT + tq) * 8 + h] = mx + __builtin_amdgcn_logf(ps);
        __syncthreads();
    }
#undef DL_PRELOAD
}
__device__ __forceinline__ void merge_scan_phase(const Args& A, int e, int G, int c) {
    int tid_ = threadIdx.x; asm volatile("" : "+v"(tid_));
    const int tid = tid_;
    int nscan = G >= 64 ? 16 : 0;
    const int nmerge = G - nscan;
    if (c >= nmerge || nscan == 0) {
        const int nthr = (nscan ? nscan : G) * 512;
        const int base = (nscan ? (c - nmerge) : c) * 512 + tid;
        const float* sst = (const float*)(A.ws + WS_Z + ZO_SST);
        bf16_t* ug = (bf16_t*)(A.ws + WS_Z + ZO_UG);
        const float* al = (const float*)(A.ws + WS_AL) + (size_t)e * 32 * 128;
        for (int id = base; id < 8192; id += nthr) {
            const int p = id & 63, g = (id >> 6) & 31, b = id >> 11;
            const float ar = al[g * 128 + p], ai = al[g * 128 + 64 + p];
            float hr = 0.f, hi = 0.f;
            const size_t row0 = (size_t)g * NCHUNK + (size_t)b * CPB;
            for (int n0 = 0; n0 < CPB; n0 += 8) {
                float sr[8], si[8];
#pragma unroll
                for (int k = 0; k < 8; ++k) { sr[k] = sst[(row0 + n0 + k) * 128 + p]; si[k] = sst[(row0 + n0 + k) * 128 + 64 + p]; }
#pragma unroll
                for (int k = 0; k < 8; ++k) {
                    bf16_t* up = ug + (row0 + n0 + k) * UGP + 512 + p;
                    up[0] = f2bf(hr); up[64] = f2bf(hi);
                    const float t = ar * hr - ai * hi + sr[k]; hi = ar * hi + ai * hr + si[k]; hr = t;
                }
            }
        }
        if (nscan) return;
    }
    const float* lse = lse_base(A);
    bf16_t* mixed = (bf16_t*)(A.ws + WS_MIXED);
    const int total = NT * 64;
    for (int i = c * 512 + tid; i < total; i += nmerge * 512) {
        const int t = i >> 6, ch = i & 63, h = ch >> 3;
        const float l0 = lse[((size_t)0 * NT + t) * 8 + h], l1 = lse[((size_t)1 * NT + t) * 8 + h], l2 = lse[((size_t)2 * NT + t) * 8 + h];
        const float m = fmaxf(l0, fmaxf(l1, l2));
        float a0 = __builtin_amdgcn_exp2f(l0 - m), a1 = __builtin_amdgcn_exp2f(l1 - m), a2 = __builtin_amdgcn_exp2f(l2 - m);
        const float inv = 1.0f / (a0 + a1 + a2); a0 *= inv; a1 *= inv; a2 *= inv;
        const u32x4 p0 = *(const u32x4*)(dilp_row(A, 0, t) + ch * 8), p1 = *(const u32x4*)(dilp_row(A, 1, t) + ch * 8), p2 = *(const u32x4*)(dilp_row(A, 2, t) + ch * 8);
        u32x4 w;
#pragma unroll
        for (int k = 0; k < 4; ++k) {
            const float lo = a0 * __uint_as_float(p0[k] << 16) + a1 * __uint_as_float(p1[k] << 16) + a2 * __uint_as_float(p2[k] << 16);
            const float hi = a0 * __uint_as_float(p0[k] & 0xffff0000u) + a1 * __uint_as_float(p1[k] & 0xffff0000u) + a2 * __uint_as_float(p2[k] & 0xffff0000u);
            w[k] = cvt_pk_bf16(lo, hi);
        }
        *(u32x4*)(mixed + (size_t)t * 1024 + 512 + ch * 8) = w;
    }
}

__device__ __forceinline__ void final_phase(const Args& A, int G, int c) {
    int tid_ = threadIdx.x; asm volatile("" : "+v"(tid_));
    const int tid = tid_, lane = tid & 63, wid = tid >> 6;
    const float* ss = (const float*)(A.ws + WS_SS);
    const bf16_t* hi = (const bf16_t*)(A.ws + WS_XB);
    const float* gw = (const float*)(A.ws + WS_MISC) + 1024;
    for (int row = c * 8 + wid; row < NT; row += G * 8) {
        const float rs = row_rs(ss, row);
        float* xr = A.out + (size_t)row * 1024;
        const bf16_t* hr = hi + (size_t)row * 1024; const bf16_t* lr = lo_row(A.out, row);
        u32x2 hv[4], lv[4];
#pragma unroll
        for (int i = 0; i < 4; ++i) { hv[i] = *(const u32x2*)(hr + i * 256 + lane * 4); if (RES_LO) lv[i] = *(const u32x2*)(lr + i * 256 + lane * 4); else { lv[i].x = 0u; lv[i].y = 0u; } }
        f32x4 v[4];
#pragma unroll
        for (int i = 0; i < 4; ++i) {
            const f32x4 g = *(const f32x4*)(gw + i * 256 + lane * 4);
            v[i][0] = (__uint_as_float(hv[i].x << 16) + __uint_as_float(lv[i].x << 16)) * rs * g[0];
            v[i][1] = (__uint_as_float(hv[i].x & 0xffff0000u) + __uint_as_float(lv[i].x & 0xffff0000u)) * rs * g[1];
            v[i][2] = (__uint_as_float(hv[i].y << 16) + __uint_as_float(lv[i].y << 16)) * rs * g[2];
            v[i][3] = (__uint_as_float(hv[i].y & 0xffff0000u) + __uint_as_float(lv[i].y & 0xffff0000u)) * rs * g[3];
        }
        asm volatile("s_waitcnt vmcnt(0)" ::: "memory");
#pragma unroll
        for (int i = 0; i < 4; ++i) *(f32x4*)(xr + i * 256 + lane * 4) = v[i];
    }
}

#define XB_TMO      128
#define XB_XCNT(j)  (256  + 64 * (j))
#define XB_XSUB(j)  (1280 + 64 * (j))
#define XB_XGEN(j)  (2304 + 64 * (j))
#define XB_TOP      3328
#define XB_TOPGEN   3392
#define XCD_BAR_WORDS 3456
#define XB_SPIN_CAP (1u << 22)
__device__ __forceinline__ unsigned xb_ld(unsigned* p)              { return __hip_atomic_load(p, __ATOMIC_RELAXED, __HIP_MEMORY_SCOPE_AGENT); }
__device__ __forceinline__ unsigned xb_add(unsigned* p, unsigned v) { return __hip_atomic_fetch_add(p, v, __ATOMIC_RELAXED, __HIP_MEMORY_SCOPE_AGENT); }
__device__ __forceinline__ unsigned xb_xcc_id() { return (unsigned)__builtin_amdgcn_s_getreg((3 << 11) | 20) & 0xFu; }
#define XB_SPIN(cond, bar) do { unsigned _sp = 0; while (cond) { __builtin_amdgcn_s_sleep(1); \
    if ((++_sp & 255u) == 0u) { if (xb_ld(&(bar)[XB_TMO])) break; if (_sp > XB_SPIN_CAP) { atomicAdd(&(bar)[XB_TMO], 1u); break; } } } } while (0)
struct XcdBarrier { unsigned* bar; unsigned x; volatile LAS unsigned* st; };
__device__ __forceinline__ XcdBarrier xcd_barrier_post(unsigned* bar, volatile LAS unsigned* st) {
    XcdBarrier b; b.bar = bar; b.x = xb_xcc_id(); b.st = st;
    if (threadIdx.x == 0) (void)xb_add(&bar[XB_XCNT(b.x)], 1u);
    return b;
}
__device__ __forceinline__ void xcd_barrier_complete(unsigned* bar, unsigned x, unsigned& nloc, unsigned& nx) {
    const unsigned G = gridDim.x * gridDim.y * gridDim.z;
    unsigned sum, cnt, mine, sp = 0u;
    for (;;) {
        sum = 0u; cnt = 0u; mine = 0u;
#pragma unroll
        for (unsigned j = 0; j < 16; ++j) { const unsigned c = xb_ld(&bar[XB_XCNT(j)]); sum += c; cnt += (c > 0u) ? 1u : 0u; mine = (j == x) ? c : mine; }
        if (sum == G) break;
        __builtin_amdgcn_s_sleep(1);
        if ((++sp & 255u) == 0u) { if (xb_ld(&bar[XB_TMO])) break; if (sp > XB_SPIN_CAP) { atomicAdd(&bar[XB_TMO], 1u); break; } }
    }
    nloc = mine > 0u ? mine : 1u; nx = cnt > 0u ? cnt : 1u;
}
__device__ __forceinline__ void xcd_barrier(unsigned* bar_, volatile LAS unsigned* st_) {
    XcdBarrier b; b.bar = bar_; b.x = xb_xcc_id(); b.st = st_;
    asm volatile("s_waitcnt vmcnt(0)" ::: "memory");
    __syncthreads();
    if (threadIdx.x == 0) {
        unsigned* bar = b.bar;
        __builtin_amdgcn_s_waitcnt(0);
        unsigned nloc = b.st[0], nx = b.st[1];
        if (nloc == 0u) { xcd_barrier_complete(bar, b.x, nloc, nx); b.st[0] = nloc; b.st[1] = nx; }
        const unsigned old = xb_add(&bar[XB_XSUB(b.x)], 1u);
        const unsigned gen = old / nloc;
        if (old + 1u == (gen + 1u) * nloc) {
            __builtin_amdgcn_fence(__ATOMIC_RELEASE, "agent");
            asm volatile("s_waitcnt vmcnt(0)" ::: "memory");
            const unsigned og = xb_add(&bar[XB_TOP], 1u);
            const unsigned tg = og / nx;
            if (og + 1u == (tg + 1u) * nx) xb_add(&bar[XB_TOPGEN], 1u);
            else XB_SPIN(xb_ld(&bar[XB_TOPGEN]) == tg, bar);
            __builtin_amdgcn_fence(__ATOMIC_ACQUIRE, "agent");
            xb_add(&bar[XB_XGEN(b.x)], 1u);
            asm volatile("s_waitcnt vmcnt(0)" ::: "memory");
        } else {
            XB_SPIN(xb_ld(&bar[XB_XGEN(b.x)]) == gen, bar);
            __builtin_amdgcn_fence(__ATOMIC_ACQUIRE, "agent");
            asm volatile("s_waitcnt vmcnt(0)" ::: "memory");
        }
    }
    __syncthreads();
}

__global__ void __launch_bounds__(512, 2) trunk_fwd(Args A) {
    extern __shared__ __attribute__((aligned(16))) unsigned char lds_raw[];
    LAS unsigned char* lds = (LAS unsigned char*)lds_raw;
    cg::grid_group grid = cg::this_grid();
    const int G = gridDim.x, c = blockIdx.x;
    volatile LAS unsigned* bst = (volatile LAS unsigned*)(lds + LDS_BARW);
    if (threadIdx.x == 0) { bst[0] = 0u; bst[1] = 0u; }
    __syncthreads();
    (void)xcd_barrier_post((unsigned*)(A.ws + WS_BAR), bst);
    if (A.ws == nullptr) grid.sync();
    unsigned char* ws = A.ws;
    float* ss = (float*)(ws + WS_SS);
    bf16_t* xb = (bf16_t*)(ws + WS_XB);
    bf16_t* mixed = (bf16_t*)(ws + WS_MIXED);
    bf16_t* zb = (bf16_t*)(ws + WS_Z);

#ifndef SKIP_PREP
    prep_phase(A, lds, G, c);
#endif
    xcd_barrier((unsigned*)(A.ws + WS_BAR), (volatile LAS unsigned*)(lds + LDS_BARW));

    for (int layer = 0; layer < 4; ++layer) {
        const int e = layer >> 1;
        if ((layer & 1) == 0) {
            {
                pg8::Gemm g{xb, (const bf16_t*)(ws + WS_EIN + e * SZ_EIN), 1024, 1024, 1024}; pg8::StaticOrder S; S.init(NT, 2048, G, c);
                EpiIn<1> E{ss, zb, (bf16_t*)(ws + WS_Z + ZO_UG)};
                pg8::gemm_phase(lds, g, S, E);
            }
            xcd_barrier((unsigned*)(A.ws + WS_BAR), (volatile LAS unsigned*)(lds + LDS_BARW));
            {
                pg8::Gemm g{(const bf16_t*)(ws + WS_Z + ZO_UG), (const bf16_t*)(ws + WS_BTF + e * SZ_BTF), UGP, 512, 512};
                pg8::GroupOrder S{128, G, c, 4, 1};
                EpiS5State E{(float*)(ws + WS_Z + ZO_SST)};
                pg8::gemm_phase(lds, g, S, E);
                __syncthreads();
#ifndef SKIP_DIL
                dilated_phase(A, lds, G, c);
#endif
            }
            xcd_barrier((unsigned*)(A.ws + WS_BAR), (volatile LAS unsigned*)(lds + LDS_BARW));
#ifndef SKIP_MS
            merge_scan_phase(A, e, G, c);
#endif
            xcd_barrier((unsigned*)(A.ws + WS_BAR), (volatile LAS unsigned*)(lds + LDS_BARW));
            {
                pg8::Gemm g{(const bf16_t*)(ws + WS_Z + ZO_UG), (const bf16_t*)(ws + WS_BTY + e * SZ_BTY), UGP, 640, 640};
                pg8::GroupOrder S{256, G, c, 4, 2};
                EpiS5Y E{(bf16_t*)(ws + WS_Z + ZO_YG)};
                pg8::gemm_phase(lds, g, S, E);
            }
            xcd_barrier((unsigned*)(A.ws + WS_BAR), (volatile LAS unsigned*)(lds + LDS_BARW));
            {
                pg8::Gemm g{(const bf16_t*)(ws + WS_Z + ZO_YG), (const bf16_t*)(ws + WS_GLU + e * SZ_GLU), 512, 512, 512}; pg8::StaticOrder S; S.init(NT, 512, G, c);
                EpiGLU E{(const bf16_t*)(ws + WS_Z + ZO_YG), (const float*)(ws + WS_MISC) + 2048 + e * 512, mixed};
                pg8::gemm_phase(lds, g, S, E);
            }
            xcd_barrier((unsigned*)(A.ws + WS_BAR), (volatile LAS unsigned*)(lds + LDS_BARW));
            {
                pg8::Gemm g{mixed, (const bf16_t*)(ws + WS_EOUT + e * SZ_SQ), 1024, 1024, 1024}; pg8::StaticOrder S; S.init(NT, 1024, G, c);
                if (layer == 0) { EpiRes<true> E{A.in[0], xb, A.out, ss}; pg8::gemm_phase(lds, g, S, E); }
                else { EpiRes<false> E{nullptr, xb, A.out, ss}; pg8::gemm_phase(lds, g, S, E); }
            }
            xcd_barrier((unsigned*)(A.ws + WS_BAR), (volatile LAS unsigned*)(lds + LDS_BARW));
        } else {
            {
                pg8::Gemm g{xb, (const bf16_t*)(ws + WS_OIN + e * SZ_OIN), 1024, 1024, 1024}; pg8::StaticOrder S; S.init(NT, 3072, G, c);
                EpiIn<0> E{ss, zb, nullptr};
                pg8::gemm_phase(lds, g, S, E);
            }
            xcd_barrier((unsigned*)(A.ws + WS_BAR), (volatile LAS unsigned*)(lds + LDS_BARW));
#ifndef SKIP_DIFF
            diff_attn_phase(A, lds, e, G, c);
#endif
            xcd_barrier((unsigned*)(A.ws + WS_BAR), (volatile LAS unsigned*)(lds + LDS_BARW));
            {
                pg8::Gemm g{mixed, (const bf16_t*)(ws + WS_OOUT + e * SZ_SQ), 1024, 1024, 1024}; pg8::StaticOrder S; S.init(NT, 1024, G, c);
                EpiRes<false> E{nullptr, xb, A.out, ss};
                pg8::gemm_phase(lds, g, S, E);
            }
            xcd_barrier((unsigned*)(A.ws + WS_BAR), (volatile LAS unsigned*)(lds + LDS_BARW));
        }
        {
            pg8::Gemm g{xb, (const bf16_t*)(ws + WS_GU + layer * SZ_GU), 1024, 1024, 1024}; pg8::StaticOrder S; S.init(NT, 5632, G, c);
            EpiSwiGLU E{ss, zb};
            pg8::gemm_phase(lds, g, S, E);
        }
        xcd_barrier((unsigned*)(A.ws + WS_BAR), (volatile LAS unsigned*)(lds + LDS_BARW));
        {
            pg8::Gemm g{zb, (const bf16_t*)(ws + WS_DN + layer * SZ_DN), DFF, DFF, DFF}; pg8::StaticOrder S; S.init(NT, 1024, G, c);
            EpiRes<false> E{nullptr, xb, A.out, ss};
            pg8::gemm_phase(lds, g, S, E);
        }
        xcd_barrier((unsigned*)(A.ws + WS_BAR), (volatile LAS unsigned*)(lds + LDS_BARW));
    }
    final_phase(A, G, c);
}

extern "C" void kernel_launch(void* const* d_in, const int* in_sizes, int n_in, void* d_out, int out_size, void* d_ws, size_t ws_size, hipStream_t stream) {
    static int grid = 0;
    if (grid == 0) {
        if (n_in != 27 || out_size != NT * 1024 || ws_size < WS_END) { fprintf(stderr, "kernel_launch: unexpected shapes (n_in %d out %d ws %zu need %zu)\n", n_in, out_size, ws_size, (size_t)WS_END); grid = -1; return; }
        int dev = 0, cus = 0, per_cu = 0;
        hipGetDevice(&dev);
        hipDeviceGetAttribute(&cus, hipDeviceAttributeMultiprocessorCount, dev);
        if (hipFuncSetAttribute((const void*)trunk_fwd, hipFuncAttributeMaxDynamicSharedMemorySize, LDS_BYTES) != hipSuccess) { fprintf(stderr, "kernel_launch: hipFuncSetAttribute failed\n"); grid = -1; return; }
        if (hipOccupancyMaxActiveBlocksPerMultiprocessor(&per_cu, (const void*)trunk_fwd, 512, LDS_BYTES) != hipSuccess || per_cu < 1) { fprintf(stderr, "kernel_launch: occupancy query says %d\n", per_cu); per_cu = 1; }
        (void)hipGetLastError();
        grid = cus;
    }
    if (grid < 0) return;
    Args a{};
    for (int i = 0; i < 27; ++i) a.in[i] = (const float*)d_in[i];
    a.out = (float*)d_out; a.ws = (unsigned char*)d_ws;
    if (hipMemsetAsync((char*)d_ws + WS_BAR, 0, 16384, stream) != hipSuccess) { fprintf(stderr, "kernel_launch: memset failed\n"); return; }
    void* args[] = {&a};
    hipError_t err = hipLaunchCooperativeKernel((const void*)trunk_fwd, dim3(grid), dim3(512), args, LDS_BYTES, stream);
    if (err != hipSuccess) fprintf(stderr, "cooperative launch failed: %s (grid %d)\n", hipGetErrorString(err), grid);
}
```

```cpp
#include <hip/hip_runtime.h>
#include <hip/hip_cooperative_groups.h>
#include <cstdio>
#include <cstdint>
namespace cg = cooperative_groups;

#define LAS __attribute__((address_space(3)))
typedef unsigned short bf16_t;
typedef short bf16x8 __attribute__((ext_vector_type(8)));
typedef short s16x4 __attribute__((ext_vector_type(4)));
typedef float f32x4 __attribute__((ext_vector_type(4)));
typedef float f32x16 __attribute__((ext_vector_type(16)));
typedef unsigned u32x4 __attribute__((ext_vector_type(4)));
typedef unsigned u32x2 __attribute__((ext_vector_type(2)));

namespace pg8 {
constexpr int BM = 256, BK = 64, HALF = 128, HTB = HALF * BK * 2, STAGE_BYTES = 8 * HTB, NXCD = 8, WGM = 8;
__host__ __device__ __forceinline__ int lds_byte(int r, int c) { const int st = (r >> 4) * 2 + (c >> 5), rr = r & 15, cc = c & 31, ob = rr * 64 + cc * 2; return st * 1024 + (ob ^ (((ob >> 9) & 1) << 5)); }
__host__ __device__ __forceinline__ void stage_rc(int b, int& R, int& C) { const int st = b / 1024, sb = b % 1024, swz = sb ^ (((sb >> 9) & 1) << 5); R = (st >> 1) * 16 + swz / 64; C = (st & 1) * 32 + (swz % 64) / 2; }
__host__ __device__ __forceinline__ int perm32(int rho) { const int n = rho >> 4, i = rho & 15; return 8 * (i >> 2) + 4 * n + (i & 3); }

struct Unit { int pm, pn; };
struct Gemm { const bf16_t* A; const bf16_t* Bt; int lda, ldb, K; int a_blk = 0; };

struct StaticOrder {
    int nM, nN, nwg, G, c;
    __host__ __device__ void init(int M, int N, int G_, int c_) { nM = M / BM; nN = N / BM; nwg = nM * nN; G = G_; c = c_; }
    __host__ __device__ bool next(int i, Unit& u) const {
        const long L = (long)i * G + c; if (L >= nwg) return false;
        int wgid = (int)L; { const int q = nwg / NXCD, r = nwg % NXCD, xcd = wgid % NXCD, off = wgid / NXCD; wgid = (xcd < r ? xcd * (q + 1) : r * (q + 1) + (xcd - r) * q) + off; }
        const int nig = WGM * nN, gid = wgid / nig, fm = gid * WGM, gsz = (nM - fm) < WGM ? (nM - fm) : WGM;
        u.pm = fm + ((wgid % nig) % gsz); u.pn = (wgid % nig) / gsz; return true;
    }
    __device__ __forceinline__ void a_ready(const Unit&) const {}
    __device__ __forceinline__ void done(const Unit&) const {}
};
struct GroupOrder {
    int total, G, c, mi, nj;
    __device__ bool next(int i, Unit& u) const {
        const int L = i * G + c; if (L >= total) return false;
        const int per = mi * nj, g = L / per, r = L % per; u.pm = g * mi + r % mi; u.pn = g * nj + r / mi; return true;
    }
    __device__ __forceinline__ void a_ready(const Unit&) const {}
    __device__ __forceinline__ void done(const Unit&) const {}
};

__device__ __forceinline__ unsigned cvt_pk_bf16(float lo, float hi) { unsigned r; asm volatile("v_cvt_pk_bf16_f32 %0, %1, %2" : "=v"(r) : "v"(lo), "v"(hi)); return r; }

template <class Epi, class Sched>
__device__ __forceinline__ void gemm_phase(LAS unsigned char* lds, const Gemm g, const Sched& S, const Epi& E) {
    int tid_ = threadIdx.x; asm volatile("" : "+v"(tid_));
    const int tid = tid_, wid = __builtin_amdgcn_readfirstlane(tid >> 6), lane = tid & 63, wr = wid >> 2, wc = wid & 3, fr = lane & 15, fq = lane >> 4;
    const int K = g.K, nt = K / BK;
    unsigned voffA[2], voffB[2];
#pragma unroll
    for (int i = 0; i < 2; ++i) { int R, C; stage_rc(tid * 16 + i * 8192, R, C); const int Rb = Epi::PERM ? ((R & ~31) + perm32(R & 31)) : R;
        voffA[i] = g.a_blk ? (unsigned)((C >> 5) * 8192 + R * 32 + (C & 31)) * 2u : (unsigned)(R * g.lda + C) * 2u; voffB[i] = (unsigned)(Rb * g.ldb + C) * 2u; }
    const size_t kstep = (size_t)(BK * 2);
    const size_t kstepA = g.a_blk ? (size_t)32768 : kstep;
    const size_t hstepA = g.a_blk ? (size_t)8192 : (size_t)HALF * g.lda * 2, hstepB = (size_t)HALF * g.ldb * 2;
    const size_t tstepA = g.a_blk ? (size_t)(g.K / BK) * 32768 : 2 * hstepA, tstepB = 2 * hstepB;
    const unsigned ldsw = (unsigned)wid * 1024u;
    const int aoff = lds_byte(wr * 64 + fr, fq * 8), boff = lds_byte(wc * 32 + fr, fq * 8);
#define PG8_SA(b, h) (((b) * 2 + (h)) * HTB)
#define PG8_SB(b, h) ((4 + (b) * 2 + (h)) * HTB)
#define PG8_STAGE(bufoff, gbase, voff) do { _Pragma("unroll") for (int _i = 0; _i < 2; ++_i) \
        __builtin_amdgcn_global_load_lds((const unsigned*)((const char*)(gbase) + (voff)[_i]), (LAS unsigned*)(lds + (bufoff) + ldsw + _i * 8192), 16, 0, 0); } while (0)
#define PG8_LDA(dst, b, h) do { _Pragma("unroll") for (int m = 0; m < 4; ++m) _Pragma("unroll") for (int k = 0; k < 2; ++k) dst[m][k] = *(const LAS bf16x8*)(lds + PG8_SA(b, h) + aoff + m * 2048 + k * 1024); } while (0)
#define PG8_LDB(dst, b, h) do { _Pragma("unroll") for (int n = 0; n < 2; ++n) _Pragma("unroll") for (int k = 0; k < 2; ++k) dst[n][k] = *(const LAS bf16x8*)(lds + PG8_SB(b, h) + boff + n * 2048 + k * 1024); } while (0)
#define PG8_MMA(ai, bj, At, Bt) do { __builtin_amdgcn_s_setprio(1); _Pragma("unroll") for (int m = 0; m < 4; ++m) _Pragma("unroll") for (int n = 0; n < 2; ++n) _Pragma("unroll") for (int k = 0; k < 2; ++k) \
        acc[ai][bj][m][n] = __builtin_amdgcn_mfma_f32_16x16x32_bf16(Bt[n][k], At[m][k], acc[ai][bj][m][n], 0, 0, 0); __builtin_amdgcn_s_setprio(0); } while (0)
#define PG8_WAIT_V(n) asm volatile("s_waitcnt vmcnt(" #n ")" ::: "memory")
#define PG8_WAIT_L(n) asm volatile("s_waitcnt lgkmcnt(" #n ")" ::: "memory")
#define PG8_BAR __builtin_amdgcn_s_barrier()
#define PG8_SCHED __builtin_amdgcn_sched_barrier(0)
    Unit cur, nxt; int ui = 0;
    if (!S.next(0, cur)) return;
    f32x4 acc[2][2][4][2];
#pragma unroll
    for (int a = 0; a < 2; ++a)
#pragma unroll
        for (int b = 0; b < 2; ++b)
#pragma unroll
            for (int m = 0; m < 4; ++m)
#pragma unroll
                for (int n = 0; n < 2; ++n) acc[a][b][m][n] = (f32x4){0.f, 0.f, 0.f, 0.f};
    bf16x8 At[4][2], B0[2][2], B1[2][2];
    const char* cA = (const char*)g.A + (size_t)cur.pm * tstepA; const char* cB = (const char*)g.Bt + (size_t)cur.pn * tstepB;
    S.a_ready(cur);
    PG8_STAGE(PG8_SB(0, 0), cB, voffB); PG8_STAGE(PG8_SB(0, 1), cB + hstepB, voffB); PG8_STAGE(PG8_SA(0, 0), cA, voffA); PG8_STAGE(PG8_SA(0, 1), cA + hstepA, voffA);
    if (wr == 1) PG8_BAR;
    PG8_WAIT_V(2); PG8_BAR;
    PG8_STAGE(PG8_SB(1, 0), cB + kstep, voffB); PG8_STAGE(PG8_SA(1, 0), cA + kstepA, voffA); PG8_STAGE(PG8_SB(1, 1), cB + hstepB + kstep, voffB);
    PG8_WAIT_V(6); PG8_BAR;
    for (;;) {
        const bool has_next = S.next(ui + 1, nxt);
        const char* nA = has_next ? (const char*)g.A + (size_t)nxt.pm * tstepA : cA; const char* nB = has_next ? (const char*)g.Bt + (size_t)nxt.pn * tstepB : cB;
        for (int t = 0; t < nt; t += 2) {
            const bool last = (t == nt - 2);
            const char* a1 = cA + (size_t)(t + 1) * kstepA;
            const char* a2 = last ? nA : cA + (size_t)(t + 2) * kstepA; const char* b2 = last ? nB : cB + (size_t)(t + 2) * kstep;
            const char* a3 = a2 + kstepA; const char* b3 = b2 + kstep;
            if (last && has_next) S.a_ready(nxt);
            PG8_LDB(B0, 0, 0); PG8_LDB(B1, 0, 1); PG8_SCHED; PG8_LDA(At, 0, 0); PG8_STAGE(PG8_SA(1, 1), a1 + hstepA, voffA);
            PG8_WAIT_V(8); PG8_WAIT_L(0); PG8_BAR; PG8_MMA(0, 0, At, B0); PG8_MMA(0, 1, At, B1); PG8_BAR; PG8_SCHED;
            PG8_LDA(At, 0, 1); PG8_STAGE(PG8_SB(0, 0), b2, voffB); PG8_STAGE(PG8_SB(0, 1), b2 + hstepB, voffB); PG8_STAGE(PG8_SA(0, 0), a2, voffA);
            PG8_WAIT_V(8); PG8_WAIT_L(0); PG8_BAR; PG8_MMA(1, 0, At, B0); PG8_MMA(1, 1, At, B1); PG8_BAR; PG8_SCHED;
            PG8_LDB(B0, 1, 0); PG8_LDB(B1, 1, 1); PG8_SCHED; PG8_LDA(At, 1, 0); PG8_STAGE(PG8_SA(0, 1), a2 + hstepA, voffA);
            PG8_WAIT_V(8); PG8_WAIT_L(0); PG8_BAR; PG8_MMA(0, 0, At, B0); PG8_MMA(0, 1, At, B1); PG8_BAR; PG8_SCHED;
            PG8_LDA(At, 1, 1); PG8_STAGE(PG8_SB(1, 0), b3, voffB); PG8_STAGE(PG8_SB(1, 1), b3 + hstepB, voffB); PG8_STAGE(PG8_SA(1, 0), a3, voffA);
            PG8_WAIT_V(8); PG8_WAIT_L(0); PG8_BAR; PG8_MMA(1, 0, At, B0); PG8_MMA(1, 1, At, B1); PG8_BAR; PG8_SCHED;
        }
        if (wr == 0) PG8_BAR;
        E(acc, cur, wr, wc, fr, fq); S.done(cur);
        if (!has_next) break;
#pragma unroll
        for (int a = 0; a < 2; ++a)
#pragma unroll
            for (int b = 0; b < 2; ++b)
#pragma unroll
                for (int m = 0; m < 4; ++m)
#pragma unroll
                    for (int n = 0; n < 2; ++n) acc[a][b][m][n] = (f32x4){0.f, 0.f, 0.f, 0.f};
        cur = nxt; cA = nA; cB = nB; ++ui;
        if (wr == 1) PG8_BAR;
    }
    PG8_WAIT_V(0);
    PG8_BAR;
#undef PG8_SA
#undef PG8_SB
#undef PG8_STAGE
#undef PG8_LDA
#undef PG8_LDB
#undef PG8_MMA
#undef PG8_WAIT_V
#undef PG8_WAIT_L
#undef PG8_BAR
#undef PG8_SCHED
}
}
using pg8::cvt_pk_bf16;

constexpr int NB = 4, SEQ = 8192, DM = 1024, NT = NB * SEQ, DFF = 2816;
constexpr int CH = 32, NCHUNK = NT / CH, CPB = SEQ / CH;
constexpr int UGP = 640;
constexpr float EPS = 1e-6f, LOG2E = 1.4426950408889634f, QSC = 0.125f * 1.4426950408889634f;

constexpr size_t al256(size_t x) { return (x + 255) & ~(size_t)255; }
constexpr size_t SZ_GU = (size_t)5632 * 1024 * 2, SZ_DN = (size_t)1024 * 2816 * 2, SZ_EIN = (size_t)2048 * 1024 * 2, SZ_SQ = (size_t)1024 * 1024 * 2,
                 SZ_GLU = (size_t)512 * 512 * 2, SZ_OIN = (size_t)3072 * 1024 * 2, SZ_BTY = (size_t)32 * 512 * 640 * 2, SZ_BTF = (size_t)32 * 256 * 512 * 2;
constexpr size_t WS_GU = 0, WS_DN = WS_GU + 4 * SZ_GU, WS_EIN = WS_DN + 4 * SZ_DN, WS_EOUT = WS_EIN + 2 * SZ_EIN, WS_GLU = WS_EOUT + 2 * SZ_SQ,
                 WS_OIN = WS_GLU + 2 * SZ_GLU, WS_OOUT = WS_OIN + 2 * SZ_OIN, WS_BTY = WS_OOUT + 2 * SZ_SQ, WS_BTF = WS_BTY + 2 * SZ_BTY,
                 WS_AL = WS_BTF + 2 * SZ_BTF, WS_LUTD = WS_AL + 32768, WS_MISC = WS_LUTD + 69632, WS_BAR = WS_MISC + 16384, WS_SS = WS_BAR + 16384,
                 WS_MIXED = WS_SS + (size_t)NT * 16 * 4, WS_Z = WS_MIXED + (size_t)NT * 1024 * 2,
                 WS_XB = WS_Z + (size_t)NT * 3072 * 2, WS_END = WS_XB + (size_t)3 * NT * 512 * 2 + (size_t)3 * NT * 8 * 4;
constexpr size_t ZO_QKV = 0, ZO_UG = (size_t)NT * 1536 * 2, ZO_SST = ZO_UG + (size_t)32 * 1024 * UGP * 2, ZO_YG = ZO_SST + (size_t)32 * 1024 * 128 * 4;
static_assert(ZO_YG + (size_t)NT * 512 * 2 <= (size_t)NT * 3072 * 2, "even-layer buffers fit the Z region");
static_assert((size_t)NT * DFF * 2 <= (size_t)NT * 3072 * 2, "act fits the Z region");
static_assert(WS_END <= (size_t)4 * NT * 1024 * 4, "workspace within 4x largest tensor");
constexpr int LDS_BYTES = 147456, LDS_BARW = LDS_BYTES - 256;
constexpr bool RES_LO = false;

struct Args {
    const float* in[27]; float* out; unsigned char* ws;
};

__device__ __forceinline__ float bf2f(bf16_t v) { return __uint_as_float(((unsigned)v) << 16); }
__device__ __forceinline__ bf16_t f2bf(float f) { unsigned u = __float_as_uint(f); return (bf16_t)((u + 0x7fffu + ((u >> 16) & 1u)) >> 16); }
__device__ __forceinline__ float wave_sum(float v) {
#pragma unroll
    for (int o = 32; o > 0; o >>= 1) v += __shfl_xor(v, o);
    return v;
}
__device__ __forceinline__ float row_rs(const float* ss, int row) {
    const f32x4* p = (const f32x4*)(ss + (size_t)row * 16);
    const f32x4 a = p[0], b = p[1], c = p[2], d = p[3];
    const float s = ((a[0] + a[1]) + (a[2] + a[3])) + ((b[0] + b[1]) + (b[2] + b[3])) + ((c[0] + c[1]) + (c[2] + c[3])) + ((d[0] + d[1]) + (d[2] + d[3]));
    return rsqrtf(s * (1.0f / 1024.0f) + EPS);
}

__device__ __forceinline__ void rows_rs(const float* ss, int rowbase, int fr, int fq, float (&rs)[2][4]) {
    f32x4 v[8];
#pragma unroll
    for (int r8 = 0; r8 < 8; ++r8) v[r8] = *(const f32x4*)(ss + (size_t)(rowbase + (r8 >> 2) * 128 + (r8 & 3) * 16 + fr) * 16 + fq * 4);
    float s[8];
#pragma unroll
    for (int r8 = 0; r8 < 8; ++r8) s[r8] = (v[r8][0] + v[r8][1]) + (v[r8][2] + v[r8][3]);
#pragma unroll
    for (int r8 = 0; r8 < 8; ++r8) s[r8] += __shfl_xor(s[r8], 16);
#pragma unroll
    for (int r8 = 0; r8 < 8; ++r8) s[r8] += __shfl_xor(s[r8], 32);
#pragma unroll
    for (int r8 = 0; r8 < 8; ++r8) rs[r8 >> 2][r8 & 3] = rsqrtf(s[r8] * (1.0f / 1024.0f) + EPS);
}

using pg8::Unit;
template <int MODE> struct EpiIn {
    static constexpr bool PERM = true;
    const float* ss; bf16_t* z; bf16_t* ug;
    __device__ __forceinline__ void operator()(const f32x4 (&acc)[2][2][4][2], const Unit& u, int wr, int wc, int fr, int fq) const {
        float rsv[2][4]; rows_rs(ss, u.pm * 256 + wr * 64, fr, fq, rsv);
#pragma unroll
        for (int ai = 0; ai < 2; ++ai)
#pragma unroll
            for (int m = 0; m < 4; ++m) {
                const int row = u.pm * 256 + ai * 128 + wr * 64 + m * 16 + fr;
                const float rs = rsv[ai][m];
#pragma unroll
                for (int bj = 0; bj < 2; ++bj) {
                    const int col = u.pn * 256 + bj * 128 + wc * 32 + 8 * fq;
                    const f32x4 v0 = acc[ai][bj][m][0] * rs, v1 = acc[ai][bj][m][1] * rs;
                    u32x4 w; w.x = cvt_pk_bf16(v0[0], v0[1]); w.y = cvt_pk_bf16(v0[2], v0[3]); w.z = cvt_pk_bf16(v1[0], v1[1]); w.w = cvt_pk_bf16(v1[2], v1[3]);
                    bf16_t* p;
                    if (MODE == 0) p = z + (size_t)row * 3072 + col;
                    else if (col < 512) p = ug + ((size_t)((col >> 4) * NCHUNK + (row >> 5)) * UGP + (row & 31) * 16 + (col & 15));
                    else p = z + (size_t)row * 1536 + (col - 512);
                    *(u32x4*)p = w;
                }
            }
    }
};
__device__ __forceinline__ bf16_t* lo_row(float* outbase, int row) { return (bf16_t*)((unsigned char*)outbase + (size_t)row * 4096 + 2048); }
template <bool FP32BASE> struct EpiRes {
    static constexpr bool PERM = true;
    const float* xin; bf16_t* hi; float* outbase; float* ss;
    __device__ __forceinline__ void operator()(const f32x4 (&acc)[2][2][4][2], const Unit& u, int wr, int wc, int fr, int fq) const {
        const int rowb = u.pm * 256 + wr * 64 + fr, colb = u.pn * 256 + wc * 32 + 8 * fq;
        f32x4 b[3][4]; u32x4 hv[3][2], lv[3][2];
#define ER_LD(r8, buf) do { const int row_ = rowb + ((r8) >> 2) * 128 + ((r8) & 3) * 16; \
        if (FP32BASE) { const float* bp_ = xin + (size_t)row_ * 1024 + colb; \
            b[buf][0] = *(const f32x4*)(bp_); b[buf][1] = *(const f32x4*)(bp_ + 4); b[buf][2] = *(const f32x4*)(bp_ + 128); b[buf][3] = *(const f32x4*)(bp_ + 132); } \
        else { const bf16_t* hp_ = hi + (size_t)row_ * 1024 + colb; const bf16_t* lp_ = lo_row(outbase, row_) + colb; \
            hv[buf][0] = *(const u32x4*)(hp_); hv[buf][1] = *(const u32x4*)(hp_ + 128); if (RES_LO) { lv[buf][0] = *(const u32x4*)(lp_); lv[buf][1] = *(const u32x4*)(lp_ + 128); } } } while (0)
        ER_LD(0, 0); ER_LD(1, 1);
#pragma unroll
        for (int r8 = 0; r8 < 8; ++r8) {
            if (r8 + 2 < 8) ER_LD(r8 + 2, (r8 + 2) % 3);
            const int ai = r8 >> 2, m = r8 & 3;
            const int row = rowb + ai * 128 + m * 16;
            float s = 0.f;
#pragma unroll
            for (int bj = 0; bj < 2; ++bj) {
                float v[8];
#pragma unroll
                for (int e = 0; e < 4; ++e) {
                    if (FP32BASE) { v[e] = acc[ai][bj][m][0][e] + b[r8 % 3][bj * 2][e]; v[4 + e] = acc[ai][bj][m][1][e] + b[r8 % 3][bj * 2 + 1][e]; }
                    else {
                        const unsigned hw = hv[r8 % 3][bj][e], lw = RES_LO ? lv[r8 % 3][bj][e] : 0u;
                        const float x0 = __uint_as_float(hw << 16) + __uint_as_float(lw << 16), x1 = __uint_as_float(hw & 0xffff0000u) + __uint_as_float(lw & 0xffff0000u);
                        const int e0 = 2 * e, e1 = 2 * e + 1;
                        v[e0] = (e0 < 4 ? acc[ai][bj][m][0][e0 & 3] : acc[ai][bj][m][1][e0 & 3]) + x0;
                        v[e1] = (e1 < 4 ? acc[ai][bj][m][0][e1 & 3] : acc[ai][bj][m][1][e1 & 3]) + x1;
                    }
                }
                u32x4 wh, wl;
#pragma unroll
                for (int k = 0; k < 4; ++k) {
                    const unsigned h2 = cvt_pk_bf16(v[2 * k], v[2 * k + 1]);
                    wh[k] = h2;
                    wl[k] = cvt_pk_bf16(v[2 * k] - __uint_as_float(h2 << 16), v[2 * k + 1] - __uint_as_float(h2 & 0xffff0000u));
                    s += v[2 * k] * v[2 * k] + v[2 * k + 1] * v[2 * k + 1];
                }
                *(u32x4*)(hi + (size_t)row * 1024 + colb + bj * 128) = wh;
                if (RES_LO) *(u32x4*)(lo_row(outbase, row) + colb + bj * 128) = wl;
            }
            s += __shfl_xor(s, 16); s += __shfl_xor(s, 32);
            if (fq == 0) ss[(size_t)row * 16 + u.pn * 4 + wc] = s;
        }
#undef ER_LD
    }
};
struct EpiSwiGLU {
    static constexpr bool PERM = true;
    const float* ss; bf16_t* act;
    __device__ __forceinline__ void operator()(const f32x4 (&acc)[2][2][4][2], const Unit& u, int wr, int wc, int fr, int fq) const {
        float rsv[2][4]; rows_rs(ss, u.pm * 256 + wr * 64, fr, fq, rsv);
#pragma unroll
        for (int ai = 0; ai < 2; ++ai)
#pragma unroll
            for (int m = 0; m < 4; ++m) {
                const int row = u.pm * 256 + ai * 128 + wr * 64 + m * 16 + fr;
                const float rs = rsv[ai][m];
                const int col = u.pn * 128 + wc * 32 + 8 * fq;
                float r[8];
#pragma unroll
                for (int n = 0; n < 2; ++n)
#pragma unroll
                    for (int e = 0; e < 4; ++e) {
                        const float g = acc[ai][0][m][n][e] * rs, up = acc[ai][1][m][n][e] * rs;
                        r[n * 4 + e] = g * up * __builtin_amdgcn_rcpf(1.0f + __expf(-g));
                    }
                u32x4 w; w.x = cvt_pk_bf16(r[0], r[1]); w.y = cvt_pk_bf16(r[2], r[3]); w.z = cvt_pk_bf16(r[4], r[5]); w.w = cvt_pk_bf16(r[6], r[7]);
                *(u32x4*)(act + ((size_t)(((row >> 8) * (DFF / 64) + (col >> 6)) * 2 + ((col >> 5) & 1)) * 8192 + (row & 255) * 32 + (col & 31))) = w;
            }
    }
};
struct EpiS5State {
    static constexpr bool PERM = false;
    float* sst;
    __device__ __forceinline__ void operator()(const f32x4 (&acc)[2][2][4][2], const Unit& u, int wr, int wc, int fr, int fq) const {
#pragma unroll
        for (int ai = 0; ai < 2; ++ai)
#pragma unroll
            for (int m = 0; m < 4; ++m) {
                const int row = u.pm * 256 + ai * 128 + wr * 64 + m * 16 + fr;
#pragma unroll
                for (int n = 0; n < 2; ++n) {
                    const int col = wc * 32 + n * 16 + 4 * fq;
                    *(f32x4*)(sst + (size_t)row * 128 + col) = acc[ai][0][m][n];
                }
            }
    }
};
__device__ __forceinline__ float gelu_tanh(float x) {
    const float t = 1.5957691216057308f * (x + 0.044715f * x * x * x);
    return x * __builtin_amdgcn_rcpf(1.0f + __expf(-t));
}
struct EpiS5Y {
    static constexpr bool PERM = true;
    bf16_t* yg;
    __device__ __forceinline__ void operator()(const f32x4 (&acc)[2][2][4][2], const Unit& u, int wr, int wc, int fr, int fq) const {
        const int g = u.pm >> 2;
#pragma unroll
        for (int ai = 0; ai < 2; ++ai)
#pragma unroll
            for (int m = 0; m < 4; ++m) {
                const int chunk = (u.pm & 3) * 256 + ai * 128 + wr * 64 + m * 16 + fr;
#pragma unroll
                for (int bj = 0; bj < 2; ++bj) {
                    const int col = (u.pn & 1) * 256 + bj * 128 + wc * 32 + 8 * fq;
                    const int tok = chunk * CH + (col >> 4);
                    const f32x4 a = acc[ai][bj][m][0], b = acc[ai][bj][m][1];
                    u32x4 w; w.x = cvt_pk_bf16(gelu_tanh(a[0]), gelu_tanh(a[1])); w.y = cvt_pk_bf16(gelu_tanh(a[2]), gelu_tanh(a[3]));
                    w.z = cvt_pk_bf16(gelu_tanh(b[0]), gelu_tanh(b[1])); w.w = cvt_pk_bf16(gelu_tanh(b[2]), gelu_tanh(b[3]));
                    *(u32x4*)(yg + (size_t)tok * 512 + g * 16 + (col & 15)) = w;
                }
            }
    }
};
struct EpiGLU {
    static constexpr bool PERM = true;
    const bf16_t* yg; const float* bias; bf16_t* mixed;
    __device__ __forceinline__ void operator()(const f32x4 (&acc)[2][2][4][2], const Unit& u, int wr, int wc, int fr, int fq) const {
        const int rowb = u.pm * 256 + wr * 64 + fr, colb = u.pn * 256 + wc * 32 + 8 * fq;
        f32x4 bb[2][2];
#pragma unroll
        for (int bj = 0; bj < 2; ++bj) { bb[bj][0] = *(const f32x4*)(bias + colb + bj * 128); bb[bj][1] = *(const f32x4*)(bias + colb + bj * 128 + 4); }
        u32x4 yv[3][2];
#define EG_LD(r8, buf) do { const bf16_t* yp_ = yg + (size_t)(rowb + ((r8) >> 2) * 128 + ((r8) & 3) * 16) * 512 + colb; \
        yv[buf][0] = *(const u32x4*)(yp_); yv[buf][1] = *(const u32x4*)(yp_ + 128); } while (0)
        EG_LD(0, 0); EG_LD(1, 1);
#pragma unroll
        for (int r8 = 0; r8 < 8; ++r8) {
            if (r8 + 2 < 8) EG_LD(r8 + 2, (r8 + 2) % 3);
            const int ai = r8 >> 2, m = r8 & 3;
            const int row = rowb + ai * 128 + m * 16;
#pragma unroll
            for (int bj = 0; bj < 2; ++bj) {
                float r[8], av[8];
#pragma unroll
                for (int e = 0; e < 4; ++e) { av[e] = acc[ai][bj][m][0][e] + bb[bj][0][e]; av[4 + e] = acc[ai][bj][m][1][e] + bb[bj][1][e]; }
#pragma unroll
                for (int k = 0; k < 4; ++k) {
                    const unsigned yw = yv[r8 % 3][bj][k];
                    const float y0 = __uint_as_float(yw << 16), y1 = __uint_as_float(yw & 0xffff0000u);
                    r[2 * k] = y0 * __builtin_amdgcn_rcpf(1.0f + __expf(-av[2 * k]));
                    r[2 * k + 1] = y1 * __builtin_amdgcn_rcpf(1.0f + __expf(-av[2 * k + 1]));
                }
                u32x4 w; w.x = cvt_pk_bf16(r[0], r[1]); w.y = cvt_pk_bf16(r[2], r[3]); w.z = cvt_pk_bf16(r[4], r[5]); w.w = cvt_pk_bf16(r[6], r[7]);
                *(u32x4*)(mixed + (size_t)row * 1024 + colb + bj * 128) = w;
            }
        }
#undef EG_LD
    }
};

__device__ __forceinline__ int rel_bucket(int d) {
    if (d < 16) return d < 0 ? 0 : d;
    const float scaled = logf((float)d / 16.0f) / 4.852030263919617f * 16.0f;
    const int large = 16 + (int)scaled;
    return large < 31 ? large : 31;
}
__device__ __forceinline__ void transpose_tile(const float* __restrict__ src, bf16_t* __restrict__ dst, const float* __restrict__ kscale, int K, int N, int mode,
                                               float cs, int cs_lo, int cs_hi, int tile, LAS float* t) {
    const int tid = threadIdx.x, tn = tile % (N / 64), tk = tile / (N / 64);
#pragma unroll
    for (int i = 0; i < 2; ++i) {
        const int r = (tid >> 4) + 32 * i, c4 = (tid & 15) * 4, k = tk * 64 + r;
        f32x4 v = *(const f32x4*)(src + (size_t)k * N + tn * 64 + c4);
        const float ks = kscale ? kscale[k] : 1.0f;
#pragma unroll
        for (int e = 0; e < 4; ++e) t[r * 65 + c4 + e] = v[e] * ks;
    }
    __syncthreads();
    {
        const int nl = tid >> 3, k8 = (tid & 7) * 8, n = tn * 64 + nl;
        const float sc = (n >= cs_lo && n < cs_hi) ? cs : 1.0f;
        float v[8];
#pragma unroll
        for (int e = 0; e < 8; ++e) v[e] = t[(k8 + e) * 65 + nl] * sc;
        u32x4 w; w.x = cvt_pk_bf16(v[0], v[1]); w.y = cvt_pk_bf16(v[2], v[3]); w.z = cvt_pk_bf16(v[4], v[5]); w.w = cvt_pk_bf16(v[6], v[7]);
        const int np = mode == 0 ? n : (256 * (n >> 7) + (mode == 2 ? 128 : 0) + (n & 127));
        *(u32x4*)(dst + (size_t)np * K + tk * 64 + k8) = w;
    }
    __syncthreads();
}

__device__ __forceinline__ void dsincos(double x, double& s, double& c) {
    const double k = rint(x * 0.15915494309189535);
    double r = fma(-k, 6.283185307179586, x); r = fma(-k, 2.4492935982947064e-16, r);
    const double r2 = r * r;
    double ts = r, tc = 1.0; s = r; c = 1.0;
    for (int n = 1; n <= 15; ++n) { tc *= -r2 / (double)((2 * n - 1) * (2 * n)); ts *= -r2 / (double)((2 * n) * (2 * n + 1)); c += tc; s += ts; }
}

__device__ __forceinline__ void s5_prep_unit(const Args& A, int e, int g, LAS unsigned char* lds) {
    const int tid = threadIdx.x;
    LAS float* apr = (LAS float*)lds;
    LAS float* api = apr + 33 * 64;
    LAS float* bbr = api + 33 * 64;
    LAS float* bbi = bbr + 1024;
    LAS float* ccr = bbi + 1024;
    LAS float* cci = ccr + 1024;
    LAS float* kl = cci + 1024;
    LAS float* cof = kl + 8192;
    const int eg = e * 32 + g;
    if (tid < 64) {
        const int p = tid;
        const double lr = (double)A.in[10][eg * 64 + p], li = (double)A.in[11][eg * 64 + p];
        const double dt = (double)expf(A.in[12][eg]);
        const double mag = exp(lr * dt); double sn, cs; dsincos(li * dt, sn, cs);
        const double ar = mag * cs, ai = mag * sn;
        const double nr = ar - 1.0, ni = ai, den = lr * lr + li * li;
        cof[2 * p] = (float)((nr * lr + ni * li) / den); cof[2 * p + 1] = (float)((ni * lr - nr * li) / den);
        double pr = 1.0, pi = 0.0;
        for (int l = 0; l <= 32; ++l) { apr[l * 64 + p] = (float)pr; api[l * 64 + p] = (float)pi; const double t = pr * ar - pi * ai; pi = pr * ai + pi * ar; pr = t; }
        float* al = (float*)(A.ws + WS_AL) + (size_t)eg * 128;
        al[p] = apr[32 * 64 + p]; al[64 + p] = api[32 * 64 + p];
    }
    __syncthreads();
    for (int i = tid; i < 1024; i += 512) {
        const int p = i >> 4;
        const float br = A.in[13][(size_t)eg * 1024 + i], bi = A.in[14][(size_t)eg * 1024 + i], cr = cof[2 * p], ci = cof[2 * p + 1];
        bbr[i] = cr * br - ci * bi; bbi[i] = cr * bi + ci * br;
        ccr[i] = A.in[15][(size_t)eg * 1024 + i]; cci[i] = A.in[16][(size_t)eg * 1024 + i];
    }
    __syncthreads();
    for (int i = tid; i < 8192; i += 512) {
        const int l = i >> 8, c = (i >> 4) & 15, cp = i & 15;
        float s = 0.f;
        for (int p = 0; p < 64; ++p) {
            const float wr_ = ccr[c * 64 + p] * apr[l * 64 + p] - cci[c * 64 + p] * api[l * 64 + p];
            const float wi_ = ccr[c * 64 + p] * api[l * 64 + p] + cci[c * 64 + p] * apr[l * 64 + p];
            s += wr_ * bbr[p * 16 + cp] - wi_ * bbi[p * 16 + cp];
        }
        if (l == 0 && c == cp) s += A.in[17][e * 512 + g * 16 + c];
        kl[i] = s;
    }
    __syncthreads();
    bf16_t* bty = (bf16_t*)(A.ws + WS_BTY + (size_t)e * SZ_BTY) + (size_t)g * 512 * 640;
    for (int i = tid; i < 512 * 320; i += 512) {
        const int rr = i / 320, k0 = (i % 320) * 2, ii = rr >> 4, c = rr & 15;
        float v[2];
#pragma unroll
        for (int q = 0; q < 2; ++q) {
            const int k = k0 + q;
            if (k < 512) { const int j = k >> 4, cp = k & 15; v[q] = (j <= ii) ? kl[(ii - j) * 256 + c * 16 + cp] : 0.f; }
            else { const int ri = (k - 512) >> 6, p = (k - 512) & 63; const float pr = apr[(ii + 1) * 64 + p], pi = api[(ii + 1) * 64 + p], cr = ccr[c * 64 + p], ci = cci[c * 64 + p];
                   v[q] = ri == 0 ? (cr * pr - ci * pi) : -(cr * pi + ci * pr); }
        }
        *(unsigned*)(bty + (size_t)rr * 640 + k0) = cvt_pk_bf16(v[0], v[1]);
    }
    bf16_t* btf = (bf16_t*)(A.ws + WS_BTF + (size_t)e * SZ_BTF) + (size_t)g * 256 * 512;
    for (int i = tid; i < 256 * 256; i += 512) {
        const int rr = i >> 8, k0 = (i & 255) * 2;
        float v[2] = {0.f, 0.f};
        if (rr < 128) {
            const int ri = rr >> 6, p = rr & 63;
#pragma unroll
            for (int q = 0; q < 2; ++q) {
                const int k = k0 + q, j = k >> 4, cp = k & 15;
                const float pr = apr[(31 - j) * 64 + p], pi = api[(31 - j) * 64 + p], br = bbr[p * 16 + cp], bi = bbi[p * 16 + cp];
                v[q] = ri == 0 ? (pr * br - pi * bi) : (pr * bi + pi * br);
            }
        }
        *(unsigned*)(btf + (size_t)rr * 512 + k0) = cvt_pk_bf16(v[0], v[1]);
    }
    __syncthreads();
}

struct TrDesc { const float* src; bf16_t* dst; const float* ks; int K, N, mode; float cs; int lo, hi, tile; };
__device__ __forceinline__ void tr_load(const TrDesc& d, int tid, f32x4 (&v)[2], float (&kv)[2]) {
    const int tn = d.tile % (d.N / 64), tk = d.tile / (d.N / 64);
#pragma unroll
    for (int i = 0; i < 2; ++i) {
        const int r = (tid >> 4) + 32 * i, c4 = (tid & 15) * 4, k = tk * 64 + r;
        v[i] = *(const f32x4*)(d.src + (size_t)k * d.N + tn * 64 + c4);
        kv[i] = d.ks ? d.ks[k] : 1.0f;
    }
}
__device__ __forceinline__ void tr_finish(const TrDesc& d, int tid, const f32x4 (&v)[2], const float (&kv)[2], LAS float* t) {
    const int tn = d.tile % (d.N / 64), tk = d.tile / (d.N / 64);
#pragma unroll
    for (int i = 0; i < 2; ++i) {
        const int r = (tid >> 4) + 32 * i, c4 = (tid & 15) * 4;
#pragma unroll
        for (int e = 0; e < 4; ++e) t[r * 65 + c4 + e] = v[i][e] * kv[i];
    }
    __syncthreads();
    {
        const int nl = tid >> 3, k8 = (tid & 7) * 8, n = tn * 64 + nl;
        const float sc = (n >= d.lo && n < d.hi) ? d.cs : 1.0f;
        float w8[8];
#pragma unroll
        for (int e = 0; e < 8; ++e) w8[e] = t[(k8 + e) * 65 + nl] * sc;
        u32x4 w; w.x = cvt_pk_bf16(w8[0], w8[1]); w.y = cvt_pk_bf16(w8[2], w8[3]); w.z = cvt_pk_bf16(w8[4], w8[5]); w.w = cvt_pk_bf16(w8[6], w8[7]);
        const int np = d.mode == 0 ? n : (256 * (n >> 7) + (d.mode == 2 ? 128 : 0) + (n & 127));
        *(u32x4*)(d.dst + (size_t)np * d.K + tk * 64 + k8) = w;
    }
    __syncthreads();
}
__device__ __forceinline__ void tr_tile(const TrDesc& d, int tid, LAS float* t) {
    const int tn = d.tile % (d.N / 128), tk = d.tile / (d.N / 128);
    f32x4 v[8]; float kv[8];
#pragma unroll
    for (int i = 0; i < 8; ++i) {
        const int idx = tid + 512 * i, r = idx >> 5, c4 = (idx & 31) * 4, k = tk * 128 + r;
        v[i] = *(const f32x4*)(d.src + (size_t)k * d.N + tn * 128 + c4);
        kv[i] = d.ks ? d.ks[k] : 1.0f;
    }
#pragma unroll
    for (int i = 0; i < 8; ++i) {
        const int idx = tid + 512 * i, r = idx >> 5, c4 = (idx & 31) * 4;
        *(LAS f32x4*)(t + r * 132 + c4) = v[i] * kv[i];
    }
    __syncthreads();
#pragma unroll
    for (int j = 0; j < 4; ++j) {
        const int pidx = tid + 512 * j, nl = pidx & 127, k8 = (pidx >> 7) * 8, n = tn * 128 + nl;
        const float sc = (n >= d.lo && n < d.hi) ? d.cs : 1.0f;
        float w8[8];
#pragma unroll
        for (int e = 0; e < 8; ++e) w8[e] = t[(k8 + e) * 132 + nl] * sc;
        u32x4 w; w.x = cvt_pk_bf16(w8[0], w8[1]); w.y = cvt_pk_bf16(w8[2], w8[3]); w.z = cvt_pk_bf16(w8[4], w8[5]); w.w = cvt_pk_bf16(w8[6], w8[7]);
        const int np = d.mode == 0 ? n : (256 * (n >> 7) + (d.mode == 2 ? 128 : 0) + (n & 127));
        *(u32x4*)(d.dst + (size_t)np * d.K + tk * 128 + k8) = w;
    }
    __syncthreads();
}
__device__ __forceinline__ void tr_decode(const Args& A, int it, TrDesc& d) {
    unsigned char* ws = A.ws;
    constexpr int T_GU = (1024 / 128) * (2816 / 128), T_DN = T_GU, T_EIN = 8 * 16, T_SQ = 64, T_GLU = 16, T_OIN = 8 * 24;
    constexpr int PER_L = 2 * T_GU + T_DN, PER_E = T_EIN + T_SQ + T_GLU + T_OIN + T_SQ;
    d.ks = nullptr; d.mode = 0; d.cs = 1.f; d.lo = 0; d.hi = 0;
    if (it < 4 * PER_L) {
        const int l = it / PER_L; int r = it % PER_L;
        if (r < 2 * T_GU) { const int up = r >= T_GU; if (up) r -= T_GU;
            d.src = A.in[up ? 6 : 5] + (size_t)l * 1024 * 2816; d.dst = (bf16_t*)(ws + WS_GU + l * SZ_GU); d.ks = A.in[3] + l * 1024; d.K = 1024; d.N = 2816; d.mode = up ? 2 : 1; d.tile = r; }
        else { r -= 2 * T_GU; d.src = A.in[7] + (size_t)l * 2816 * 1024; d.dst = (bf16_t*)(ws + WS_DN + l * SZ_DN); d.K = 2816; d.N = 1024; d.tile = r; }
    } else {
        it -= 4 * PER_L; const int l = it / PER_E; int r = it % PER_E;
        if (r < T_EIN) { d.src = A.in[8] + (size_t)l * 1024 * 2048; d.dst = (bf16_t*)(ws + WS_EIN + l * SZ_EIN); d.ks = A.in[2] + (2 * l) * 1024; d.K = 1024; d.N = 2048; d.cs = QSC; d.lo = 512; d.hi = 1024; d.tile = r; return; } r -= T_EIN;
        if (r < T_SQ) { d.src = A.in[9] + (size_t)l * 1024 * 1024; d.dst = (bf16_t*)(ws + WS_EOUT + l * SZ_SQ); d.K = 1024; d.N = 1024; d.tile = r; return; } r -= T_SQ;
        if (r < T_GLU) { d.src = A.in[18] + (size_t)l * 512 * 512; d.dst = (bf16_t*)(ws + WS_GLU + l * SZ_GLU); d.K = 512; d.N = 512; d.tile = r; return; } r -= T_GLU;
        if (r < T_OIN) { d.src = A.in[20] + (size_t)l * 1024 * 3072; d.dst = (bf16_t*)(ws + WS_OIN + l * SZ_OIN); d.ks = A.in[2] + (2 * l + 1) * 1024; d.K = 1024; d.N = 3072; d.cs = QSC; d.lo = 0; d.hi = 1024; d.tile = r; return; } r -= T_OIN;
        d.src = A.in[21] + (size_t)l * 1024 * 1024; d.dst = (bf16_t*)(ws + WS_OOUT + l * SZ_SQ); d.K = 1024; d.N = 1024; d.tile = r;
    }
}

__device__ __forceinline__ void prep_phase(const Args& A, LAS unsigned char* lds, int G, int c) {
    int tid_ = threadIdx.x; asm volatile("" : "+v"(tid_));
    const int tid = tid_, lane = tid & 63, wid = tid >> 6;
    unsigned char* ws = A.ws;
    constexpr int T_GU = (1024 / 128) * (2816 / 128), T_DN = T_GU, T_EIN = 8 * 16, T_SQ = 64, T_GLU = 16, T_OIN = 8 * 24;
    constexpr int N_TR = 4 * (2 * T_GU + T_DN) + 2 * (T_EIN + T_SQ + T_GLU + T_OIN + T_SQ);
    constexpr int N_XB = NT / 8;
    for (int it = c; it < 65; it += G) {
        if (it < 64) { s5_prep_unit(A, it >> 5, it & 31, lds); continue; }
        float* lut = (float*)(ws + WS_LUTD);
        for (int i = tid; i < 8 * 2176; i += 512) { const int h = i / 2176, d = i % 2176 - 128; lut[i] = d < 0 ? -1e30f : A.in[1][rel_bucket(d) * 16 + 8 + h] * LOG2E; }
        {
            float* m = (float*)(ws + WS_MISC);
            m[256 + tid] = A.in[1][tid];
            m[1024 + tid] = A.in[4][tid]; m[1536 + tid] = A.in[4][512 + tid];
            m[2048 + tid] = A.in[19][tid]; m[2560 + tid] = A.in[19][512 + tid];
            if (tid < 256) m[3072 + tid] = A.in[26][tid];
        }
        if (wid < 2) {
            const int o = wid;
            float a = A.in[22][o * 64 + lane] * A.in[23][o * 64 + lane], b = A.in[24][o * 64 + lane] * A.in[25][o * 64 + lane];
            a = wave_sum(a); b = wave_sum(b);
            const float lam_init = 0.8f - 0.6f * expf(-0.3f * (float)(2 * o + 1));
            if (lane == 0) { float* m = (float*)(ws + WS_MISC); m[o * 2] = expf(a) - expf(b) + lam_init; m[o * 2 + 1] = 1.0f - lam_init; }
        }
    }
    __syncthreads();
    {
        LAS float* t = (LAS float*)lds;
        if (G == 256) { if (c >= 65) for (int it = c - 65; it < N_TR; it += G - 65) { TrDesc d0; tr_decode(A, it, d0); tr_tile(d0, tid, t); } }
        else for (int it = c; it < N_TR; it += G) { TrDesc d0; tr_decode(A, it, d0); tr_tile(d0, tid, t); }
    }
    for (int it = (G == 256 ? (c >= 65 ? c - 65 : N_XB) : c); it < N_XB; it += (G == 256 ? G - 65 : G)) {
        const int row = it * 8 + wid;
        const float* xr = A.in[0] + (size_t)row * 1024;
        bf16_t* xo = (bf16_t*)(ws + WS_XB) + (size_t)row * 1024;
        float s = 0.f;
#pragma unroll
        for (int i = 0; i < 4; ++i) {
            const f32x4 v = *(const f32x4*)(xr + i * 256 + lane * 4);
            s += (v[0] * v[0] + v[1] * v[1]) + (v[2] * v[2] + v[3] * v[3]);
            u32x2 w; w.x = cvt_pk_bf16(v[0], v[1]); w.y = cvt_pk_bf16(v[2], v[3]);
            *(u32x2*)(xo + i * 256 + lane * 4) = w;
        }
        s = wave_sum(s);
        if (lane < 16) ((float*)(ws + WS_SS))[(size_t)row * 16 + lane] = lane == 0 ? s : 0.f;
    }
}

constexpr int DA_KP = 144, DA_VP = 320, DA_K2 = 64 * DA_KP, DA_KST = 2 * DA_K2, DA_VST = 64 * DA_VP, DA_VOFF = 2 * DA_KST, DA_LUT = DA_VOFF + 3 * DA_VST, DA_Q = DA_LUT + 8704;
static_assert(DA_Q + 32768 <= LDS_BARW && 128 * 132 * 4 <= DA_LUT, "diff attention LDS map");
constexpr float DA_THR = 6.0f;
__device__ __forceinline__ s16x4 tr_read(LAS const unsigned char* p) {
    typedef short v4i16_t __attribute__((ext_vector_type(4)));
    return __builtin_bit_cast(s16x4, __builtin_amdgcn_ds_read_tr16_b64_v4i16((LAS v4i16_t*)p));
}
__device__ __forceinline__ void da_qk(f32x16& s0, f32x16& s1, LAS const unsigned char* kb, LAS const unsigned char* qb, LAS const float* lut, int qpos, int qrow0, int kt, int hh) {
    const int dmin = qrow0 - (kt * 64 + 63);
    if (dmin >= 1513) {
#pragma unroll
        for (int r = 0; r < 16; ++r) { s0[r] = 0.f; s1[r] = 0.f; }
    } else {
        LAS const float* lp = lut + (128 - 59 + qpos - kt * 64 - 4 * hh);
#pragma unroll
        for (int r = 0; r < 16; ++r) { const int cr = (r & 3) + 8 * (r >> 2); s0[r] = lp[59 - cr]; s1[r] = lp[27 - cr]; }
    }
#pragma unroll
    for (int d = 0; d < 4; ++d) {
        const bf16x8 a0 = *(LAS const bf16x8*)(kb + d * 32), a1 = *(LAS const bf16x8*)(kb + 32 * DA_KP + d * 32);
        const bf16x8 q = *(LAS const bf16x8*)(qb + d * 1024);
        s0 = __builtin_amdgcn_mfma_f32_32x32x16_bf16(a0, q, s0, 0, 0, 0);
        s1 = __builtin_amdgcn_mfma_f32_32x32x16_bf16(a1, q, s1, 0, 0, 0);
    }
}
__device__ __forceinline__ void da_pv(f32x16 (&oacc)[4], LAS const unsigned char* vb, const bf16x8 (&pf)[4]) {
#pragma unroll
    for (int sk = 0; sk < 4; ++sk) {
#pragma unroll
        for (int dv = 0; dv < 4; ++dv) {
            const s16x4 lo = tr_read(vb + (16 * sk) * DA_VP + dv * 64), hi = tr_read(vb + (16 * sk + 8) * DA_VP + dv * 64);
            const bf16x8 vf = (bf16x8){lo[0], lo[1], lo[2], lo[3], hi[0], hi[1], hi[2], hi[3]};
            oacc[dv] = __builtin_amdgcn_mfma_f32_32x32x16_bf16(vf, pf[sk], oacc[dv], 0, 0, 0);
        }
        __builtin_amdgcn_sched_barrier(0);
    }
}
__device__ __forceinline__ float max3f(float a, float b, float c) { return fmaxf(fmaxf(a, b), c); }
__device__ __forceinline__ void da_smax(f32x16& s0, f32x16& s1, LAS const float* lut, float bfar, int qpos, int qrow0, int kt, int hh,
                                        float& mref, float& lrun, f32x16 (&oacc)[4], bf16x8 (&pfp)[4], float& moff) {
    const float badd = (qrow0 - (kt * 64 + 63) >= 1513) ? bfar : 0.f;
    float ma = max3f(s0[0], s0[1], s0[2]), mb = max3f(s1[0], s1[1], s1[2]);
    ma = max3f(ma, s0[3], s0[4]); mb = max3f(mb, s1[3], s1[4]);
    ma = max3f(ma, s0[5], s0[6]); mb = max3f(mb, s1[5], s1[6]);
    ma = max3f(ma, s0[7], s0[8]); mb = max3f(mb, s1[7], s1[8]);
    ma = max3f(ma, s0[9], s0[10]); mb = max3f(mb, s1[9], s1[10]);
    ma = max3f(ma, s0[11], s0[12]); mb = max3f(mb, s1[11], s1[12]);
    ma = max3f(ma, s0[13], s0[14]); mb = max3f(mb, s1[13], s1[14]);
    float mx = max3f(ma, mb, fmaxf(s0[15], s1[15]));
    mx = fmaxf(mx, __shfl_xor(mx, 32)) + badd;
    if (__builtin_amdgcn_ballot_w64(mx > mref + DA_THR) != 0ull) {
        const float mnew = fmaxf(mref, mx), alpha = __builtin_amdgcn_exp2f(mref - mnew);
        mref = mnew; lrun *= alpha;
#pragma unroll
        for (int i = 0; i < 4; ++i)
#pragma unroll
            for (int r = 0; r < 16; ++r) oacc[i][r] *= alpha;
#pragma unroll
        for (int i = 0; i < 4; ++i) {
            u32x4 w = __builtin_bit_cast(u32x4, pfp[i]);
#pragma unroll
            for (int k = 0; k < 4; ++k) w[k] = cvt_pk_bf16(__uint_as_float(w[k] << 16) * alpha, __uint_as_float(w[k] & 0xffff0000u) * alpha);
            pfp[i] = __builtin_bit_cast(bf16x8, w);
        }
    }
    moff = mref - badd;
}
__device__ __forceinline__ void da_exp(f32x16& s0, f32x16& s1, float moff, float& lrun) {
    float pa = 0.f, pb = 0.f;
#pragma unroll
    for (int r = 0; r < 16; ++r) { s0[r] = __builtin_amdgcn_exp2f(s0[r] - moff); s1[r] = __builtin_amdgcn_exp2f(s1[r] - moff); pa += s0[r]; pb += s1[r]; }
    lrun += pa + pb;
}
__device__ __forceinline__ void da_pack(const f32x16& s0, const f32x16& s1, bf16x8 (&pf)[4]) {
#pragma unroll
    for (int k2 = 0; k2 < 2; ++k2) {
        u32x4 w0, w1;
        w0.x = cvt_pk_bf16(s0[8 * k2 + 0], s0[8 * k2 + 1]); w0.y = cvt_pk_bf16(s0[8 * k2 + 2], s0[8 * k2 + 3]); w0.z = cvt_pk_bf16(s0[8 * k2 + 4], s0[8 * k2 + 5]); w0.w = cvt_pk_bf16(s0[8 * k2 + 6], s0[8 * k2 + 7]);
        w1.x = cvt_pk_bf16(s1[8 * k2 + 0], s1[8 * k2 + 1]); w1.y = cvt_pk_bf16(s1[8 * k2 + 2], s1[8 * k2 + 3]); w1.z = cvt_pk_bf16(s1[8 * k2 + 4], s1[8 * k2 + 5]); w1.w = cvt_pk_bf16(s1[8 * k2 + 6], s1[8 * k2 + 7]);
        pf[k2] = __builtin_bit_cast(bf16x8, w0); pf[2 + k2] = __builtin_bit_cast(bf16x8, w1);
    }
}
#define DA_TR2(lo, hi, base, o1, o2) asm volatile("ds_read_b64_tr_b16 %0, %2 offset:%c3\n\tds_read_b64_tr_b16 %1, %2 offset:%c4" : "=&v"(lo), "=&v"(hi) : "v"(base), "i"(o1), "i"(o2) : "memory")
template <bool DO_EXP>
__device__ __forceinline__ void da_pvexp(f32x16 (&oacc)[4], unsigned vb, const bf16x8 (&pf)[4], f32x16& s0, f32x16& s1, float moff, float& lrun) {
    s16x4 lo[2][4], hi[2][4];
    float pa = 0.f, pb = 0.f;
#pragma unroll
    for (int dv = 0; dv < 4; ++dv) DA_TR2(lo[0][dv], hi[0][dv], vb, dv * 64, 8 * DA_VP + dv * 64);
#pragma unroll
    for (int g = 0; g < 4; ++g) {
        if (DO_EXP) {
#pragma unroll
            for (int r = 4 * g; r < 4 * g + 4; ++r) { s0[r] = __builtin_amdgcn_exp2f(s0[r] - moff); s1[r] = __builtin_amdgcn_exp2f(s1[r] - moff); pa += s0[r]; pb += s1[r]; }
        }
        if (g < 3) {
#pragma unroll
            for (int dv = 0; dv < 4; ++dv) DA_TR2(lo[(g + 1) & 1][dv], hi[(g + 1) & 1][dv], vb, (16 * (g + 1)) * DA_VP + dv * 64, (16 * (g + 1) + 8) * DA_VP + dv * 64);
            asm volatile("s_waitcnt lgkmcnt(8)" ::: "memory");
        } else asm volatile("s_waitcnt lgkmcnt(0)" ::: "memory");
        __builtin_amdgcn_sched_barrier(0);
#pragma unroll
        for (int dv = 0; dv < 4; ++dv) {
            const s16x4 l = lo[g & 1][dv], h = hi[g & 1][dv];
            const bf16x8 vf = (bf16x8){l[0], l[1], l[2], l[3], h[0], h[1], h[2], h[3]};
            oacc[dv] = __builtin_amdgcn_mfma_f32_32x32x16_bf16(vf, pf[g], oacc[dv], 0, 0, 0);
        }
        __builtin_amdgcn_sched_barrier(0);
    }
    lrun += pa + pb;
}
__device__ __forceinline__ void diff_attn_phase(const Args& A, LAS unsigned char* lds, int o, int G, int c) {
    int tid_ = threadIdx.x; asm volatile("" : "+v"(tid_));
    const int wid = __builtin_amdgcn_readfirstlane(tid_ >> 6);
    const int st = wid >> 2, qt = wid & 3;
    const bf16_t* z = (const bf16_t*)(A.ws + WS_Z);
    bf16_t* mixed = (bf16_t*)(A.ws + WS_MIXED);
    const float* lutg = (const float*)(A.ws + WS_LUTD);
    const float lam = ((const float*)(A.ws + WS_MISC))[o * 2], oscale = ((const float*)(A.ws + WS_MISC))[o * 2 + 1];
    const float* subg = (const float*)(A.ws + WS_MISC) + 3072 + o * 128;
    LAS float* lut = (LAS float*)(lds + DA_LUT);
    LAS float* exch = (LAS float*)lds;
    constexpr int NUNITS = NB * 8 * 64;
    for (int ui = c; ui < NUNITS; ui += G) {
        int tid_u = tid_; asm volatile("" : "+v"(tid_u));
        const int tid = tid_u, lane = tid & 63, qi = lane & 31, hh = lane >> 5;
        const int round = ui / 256, cc = ui % 256;
        int qb, bh;
        if (G == 256) {
            const int x = cc & 7, j = cc >> 3; bh = (round >> 1) * 8 + x; qb = (round & 1) ? j : 63 - j; }
        else { qb = 63 - (ui >> 5); bh = ui & 31; }
        const int b = bh >> 3, h = bh & 7;
        const int nt = 2 * (qb + 1);
        const size_t tok0 = (size_t)b * SEQ;
        for (int i = tid; i < 544; i += 512) *(LAS f32x4*)(lut + i * 4) = *(const f32x4*)(lutg + h * 2176 + i * 4);
        LAS unsigned char* qfl = lds + DA_Q + wid * 4096 + lane * 16;
        {
            const bf16_t* qp = z + (tok0 + qb * 128 + qt * 32 + qi) * 3072 + h * 128 + st * 64 + hh * 8;
#pragma unroll
            for (int d = 0; d < 4; ++d) *(LAS bf16x8*)(qfl + d * 1024) = *(const bf16x8*)(qp + d * 16);
        }
        const int kr = tid >> 3, kc = tid & 7;
        const bf16_t* kp1 = z + (tok0 + kr) * 3072 + 1024 + h * 128 + kc * 8;
        const int vr0 = tid >> 4, vc = tid & 15;
        const bf16_t* vp = z + (tok0 + vr0) * 3072 + 2048 + h * 128 + vc * 8;
        const unsigned kwo = kr * DA_KP + kc * 16, vwo = vr0 * DA_VP + vc * 16;
        constexpr size_t TS = (size_t)64 * 3072;
        u32x4 rk1, rk2, rv0, rv1, bk1, bk2, bv0, bv1;
#define DA_LDK(t) do { rk1 = *(const u32x4*)(kp1 + (size_t)(t) * TS); rk2 = *(const u32x4*)(kp1 + (size_t)(t) * TS + 64); } while (0)
#define DA_LDV(t) do { rv0 = *(const u32x4*)(vp + (size_t)(t) * TS); rv1 = *(const u32x4*)(vp + (size_t)(t) * TS + (size_t)32 * 3072); } while (0)
#define DA_LDKB(t) do { bk1 = *(const u32x4*)(kp1 + (size_t)(t) * TS); bk2 = *(const u32x4*)(kp1 + (size_t)(t) * TS + 64); } while (0)
#define DA_LDVB(t) do { bv0 = *(const u32x4*)(vp + (size_t)(t) * TS); bv1 = *(const u32x4*)(vp + (size_t)(t) * TS + (size_t)32 * 3072); } while (0)
#define DA_STK(t) do { LAS unsigned char* sw_ = lds + ((t) & 1) * DA_KST; *(LAS u32x4*)(sw_ + kwo) = rk1; *(LAS u32x4*)(sw_ + DA_K2 + kwo) = rk2; } while (0)
#define DA_STV(t) do { LAS unsigned char* sw_ = lds + DA_VOFF + ((t) % 3) * DA_VST; *(LAS u32x4*)(sw_ + vwo) = rv0; *(LAS u32x4*)(sw_ + 32 * DA_VP + vwo) = rv1; } while (0)
        DA_LDK(0); DA_LDV(0); DA_STK(0); DA_STV(0);
        DA_LDK(1); DA_STK(1);
        __syncthreads();
        f32x16 oacc[4];
#pragma unroll
        for (int i = 0; i < 4; ++i)
#pragma unroll
            for (int r = 0; r < 16; ++r) oacc[i][r] = 0.f;
        float mref = -1e30f, lrun = 0.f, moff;
        const int qrow0 = qb * 128 + qt * 32, qpos = qrow0 + qi;
        const float bfar = lut[2175];
        const unsigned kro = st * DA_K2 + qi * DA_KP + hh * 16;
        const unsigned vro = DA_VOFF + (4 * hh + ((lane & 15) >> 2)) * DA_VP + (16 * ((lane >> 4) & 1) + 4 * (lane & 3)) * 2;
        f32x16 s0, s1;
        bf16x8 pfp[4];
#pragma unroll
        for (int i = 0; i < 4; ++i) pfp[i] = (bf16x8){0, 0, 0, 0, 0, 0, 0, 0};
        da_qk(s0, s1, lds + kro, qfl, lut, qpos, qrow0, 0, hh);
        __syncthreads();
        if (nt > 2) DA_LDK(2);
        DA_LDV(1);
        if (nt > 3) DA_LDKB(3);
        if (nt > 2) DA_LDVB(2);
        da_smax(s0, s1, lut, bfar, qpos, qrow0, 0, hh, mref, lrun, oacc, pfp, moff);
        da_exp(s0, s1, moff, lrun);
        da_pack(s0, s1, pfp);
        da_qk(s0, s1, lds + DA_KST + kro, qfl, lut, qpos, qrow0, 1, hh);
        if (nt > 2) DA_STK(2);
        DA_STV(1);
        __syncthreads();
        rk1 = bk1; rk2 = bk2; rv0 = bv0; rv1 = bv1;
        for (int kt = 1; kt < nt; ++kt) {
            if (kt + 3 < nt) DA_LDKB(kt + 3);
            if (kt + 2 < nt) DA_LDVB(kt + 2);
            da_smax(s0, s1, lut, bfar, qpos, qrow0, kt, hh, mref, lrun, oacc, pfp, moff);
            da_pvexp<true>(oacc, (unsigned)(size_t)(lds + vro + ((kt - 1) % 3) * DA_VST), pfp, s0, s1, moff, lrun);
            da_pack(s0, s1, pfp);
            { const int tn = kt + 1 < nt ? kt + 1 : nt - 1; da_qk(s0, s1, lds + (tn & 1) * DA_KST + kro, qfl, lut, qpos, qrow0, tn, hh); }
            if (kt + 2 < nt) DA_STK(kt + 2);
            if (kt + 1 < nt) DA_STV(kt + 1);
            __syncthreads();
            rk1 = bk1; rk2 = bk2; rv0 = bv0; rv1 = bv1;
        }
        da_pvexp<false>(oacc, (unsigned)(size_t)(lds + vro + ((nt - 1) % 3) * DA_VST), pfp, s0, s1, moff, lrun);
#undef DA_LDK
#undef DA_LDKB
#undef DA_LDVB
#undef DA_LDV
#undef DA_STK
#undef DA_STV
        __syncthreads();
        const float ltot = lrun + __shfl_xor(lrun, 32);
        const float inv = 1.0f / ltot;
        const int ql = qt * 32 + qi;
        if (st == 1) {
            const float f = inv * lam;
#pragma unroll
            for (int dv = 0; dv < 4; ++dv)
#pragma unroll
                for (int i = 0; i < 4; ++i) {
                    f32x4 v; v[0] = oacc[dv][4 * i] * f; v[1] = oacc[dv][4 * i + 1] * f; v[2] = oacc[dv][4 * i + 2] * f; v[3] = oacc[dv][4 * i + 3] * f;
                    *(LAS f32x4*)(exch + ql * 132 + dv * 32 + 8 * i + 4 * hh) = v;
                }
        }
        __syncthreads();
        if (st == 0) {
            float ssq = 0.f;
#pragma unroll
            for (int dv = 0; dv < 4; ++dv)
#pragma unroll
                for (int i = 0; i < 4; ++i) {
                    const f32x4 e = *(LAS const f32x4*)(exch + ql * 132 + dv * 32 + 8 * i + 4 * hh);
#pragma unroll
                    for (int j = 0; j < 4; ++j) { const float a = oacc[dv][4 * i + j] * inv - e[j]; oacc[dv][4 * i + j] = a; ssq += a * a; }
                }
            ssq += __shfl_xor(ssq, 32);
            const float rn = rsqrtf(ssq * (1.0f / 128.0f) + EPS) * oscale;
            bf16_t* op = mixed + (tok0 + qb * 128 + ql) * 1024 + h * 128;
#pragma unroll
            for (int dv = 0; dv < 4; ++dv)
#pragma unroll
                for (int i = 0; i < 4; ++i) {
                    const int d = dv * 32 + 8 * i + 4 * hh;
                    const f32x4 gg = *(const f32x4*)(subg + d);
                    u32x2 w; w.x = cvt_pk_bf16(oacc[dv][4 * i] * rn * gg[0], oacc[dv][4 * i + 1] * rn * gg[1]); w.y = cvt_pk_bf16(oacc[dv][4 * i + 2] * rn * gg[2], oacc[dv][4 * i + 3] * rn * gg[3]);
                    *(u32x2*)(op + d) = w;
                }
        }
        __syncthreads();
    }
}

__device__ __forceinline__ bf16_t* dilp_row(const Args& A, int pat, size_t t) {
    return pat < 2 ? (bf16_t*)((unsigned char*)A.out + t * 4096 + pat * 1024) : (bf16_t*)(A.ws + WS_XB + (size_t)NT * 2048) + t * 512;
}
__device__ __forceinline__ float* lse_base(const Args& A) { return (float*)(A.ws + WS_XB + (size_t)NT * 2048 + (size_t)NT * 1024); }
constexpr int DL_KP = 144, DL_VP = 192, DL_V = 384 * DL_KP, DL_LUT = DL_V + 384 * DL_VP;
static_assert(DL_LUT + 1024 <= LDS_BARW, "dilated LDS map");
__device__ __forceinline__ void dilated_phase(const Args& A, LAS unsigned char* lds, int G, int c) {
    int tid_ = threadIdx.x; asm volatile("" : "+v"(tid_));
    const int tid = tid_, lane = tid & 63, wid = __builtin_amdgcn_readfirstlane(tid >> 6);
    const int qi = lane & 31, hh = lane >> 5, bsel = wid >> 2, qt = wid & 3;
    const bf16_t* qkv = (const bf16_t*)(A.ws + WS_Z + ZO_QKV);
    float* lse = lse_base(A);
    LAS float* dlut = (LAS float*)(lds + DL_LUT);
    constexpr int NUNITS = 3 * NB * 8 * 32;
    int u_lo, u_hi;
    if (G == 256) {
        if (c < 128) { u_lo = c * 11; u_hi = u_lo + 11; } else { u_lo = 128 * 11 + (c - 128) * 13; u_hi = u_lo + 13; }
    } else { const int per = (NUNITS + G - 1) / G; u_lo = c * per; u_hi = (u_lo + per) < NUNITS ? (u_lo + per) : NUNITS; }
    u32x4 pk[6], pv[6];
#define DL_PRELOAD(UI) do { const int bp_ = (UI) & 31, h_ = ((UI) >> 5) & 7, b_ = ((UI) >> 8) & 3, pat_ = (UI) >> 10; \
        const int r_ = pat_ == 0 ? 1 : (pat_ == 1 ? 4 : 16), nbp_ = 32 / r_, rho_ = bp_ / nbp_, n0_ = 2 * (bp_ % nbp_); const size_t tok0_ = (size_t)b_ * SEQ; \
        _Pragma("unroll") for (int i = 0; i < 6; ++i) { const int idx = tid + 512 * i, row = idx >> 3, ch = idx & 7; int ip = row; if (n0_ == 0 && ip < 128) ip += 128; \
            const size_t tk = tok0_ + (size_t)((128 * (n0_ - 1) + ip) * r_ + rho_); \
            pk[i] = *(const u32x4*)(qkv + tk * 1536 + 512 + h_ * 64 + ch * 8); pv[i] = *(const u32x4*)(qkv + tk * 1536 + 1024 + h_ * 64 + ch * 8); } } while (0)
    if (u_lo < u_hi) DL_PRELOAD(u_lo);
    for (int ui = u_lo; ui < u_hi; ++ui) {
        const int bp = ui & 31, h = (ui >> 5) & 7, b = (ui >> 8) & 3, pat = ui >> 10;
        const int r = pat == 0 ? 1 : (pat == 1 ? 4 : 16);
        const int nbp = 32 / r, rho = bp / nbp, n0 = 2 * (bp % nbp);
        const size_t tok0 = (size_t)b * SEQ;
        if (tid < 256) { const int st_ = tid - 64; dlut[tid] = (st_ >= 0 && st_ <= 128) ? ((const float*)(A.ws + WS_MISC))[256 + rel_bucket(st_ * r) * 16 + h] * LOG2E : -1e30f; }
#pragma unroll
        for (int i = 0; i < 6; ++i) {
            const int idx = tid + 512 * i, row = idx >> 3, ch = idx & 7;
            *(LAS u32x4*)(lds + row * DL_KP + ch * 16) = pk[i];
            *(LAS u32x4*)(lds + DL_V + row * DL_VP + ch * 16) = pv[i];
        }
        const int n = n0 + bsel;
        const int iq = 32 * qt + qi;
        const size_t tq = tok0 + (size_t)((128 * n + iq) * r + rho);
        bf16x8 qf[4];
#pragma unroll
        for (int d = 0; d < 4; ++d) qf[d] = *(const bf16x8*)(qkv + tq * 1536 + h * 64 + d * 16 + hh * 8);
        __syncthreads();
        if (ui + 1 < u_hi) DL_PRELOAD(ui + 1);
        const int jb = 128 * bsel + 32 * qt;
        LAS const float* lp = dlut + (64 + 128 - 155 + qi - 4 * hh);
        LAS const unsigned char* kb = lds + (jb + qi) * DL_KP + hh * 16;
        f32x16 sc[5];
#pragma unroll
        for (int t = 0; t < 5; ++t) {
            f32x16 acc;
#pragma unroll
            for (int rr = 0; rr < 16; ++rr) acc[rr] = lp[155 - 32 * t - ((rr & 3) + 8 * (rr >> 2))];
#pragma unroll
            for (int d = 0; d < 4; ++d) acc = __builtin_amdgcn_mfma_f32_32x32x16_bf16(*(LAS const bf16x8*)(kb + (32 * t) * DL_KP + d * 32), qf[d], acc, 0, 0, 0);
            if (n == 0) {
#pragma unroll
                for (int rr = 0; rr < 16; ++rr) { const int ip = 32 * qt + 32 * t + (rr & 3) + 8 * (rr >> 2) + 4 * hh; if (ip < 128) acc[rr] = -1e30f; }
            }
            sc[t] = acc;
        }
        float mx = -1e30f;
#pragma unroll
        for (int t = 0; t < 5; ++t)
#pragma unroll
            for (int rr = 0; rr < 16; ++rr) mx = fmaxf(mx, sc[t][rr]);
        mx = fmaxf(mx, __shfl_xor(mx, 32));
        float ps = 0.f;
#pragma unroll
        for (int t = 0; t < 5; ++t)
#pragma unroll
            for (int rr = 0; rr < 16; ++rr) { sc[t][rr] = __builtin_amdgcn_exp2f(sc[t][rr] - mx); ps += sc[t][rr]; }
        ps += __shfl_xor(ps, 32);
        f32x16 oacc[2];
#pragma unroll
        for (int i = 0; i < 2; ++i)
#pragma unroll
            for (int rr = 0; rr < 16; ++rr) oacc[i][rr] = 0.f;
        const unsigned vb = (unsigned)(size_t)(lds + DL_V + (jb + 4 * hh + ((lane & 15) >> 2)) * DL_VP + (16 * ((lane >> 4) & 1) + 4 * (lane & 3)) * 2);
#pragma unroll
        for (int t = 0; t < 5; ++t) {
            s16x4 lo[4], hi[4];
#pragma unroll
            for (int s2 = 0; s2 < 2; ++s2)
#pragma unroll
                for (int dvt = 0; dvt < 2; ++dvt) DA_TR2(lo[s2 * 2 + dvt], hi[s2 * 2 + dvt], vb, (32 * t + 16 * s2) * DL_VP + dvt * 64, (32 * t + 16 * s2 + 8) * DL_VP + dvt * 64);
            bf16x8 pf[2];
#pragma unroll
            for (int s2 = 0; s2 < 2; ++s2) {
                u32x4 w; w.x = cvt_pk_bf16(sc[t][8 * s2 + 0], sc[t][8 * s2 + 1]); w.y = cvt_pk_bf16(sc[t][8 * s2 + 2], sc[t][8 * s2 + 3]);
                w.z = cvt_pk_bf16(sc[t][8 * s2 + 4], sc[t][8 * s2 + 5]); w.w = cvt_pk_bf16(sc[t][8 * s2 + 6], sc[t][8 * s2 + 7]);
                pf[s2] = __builtin_bit_cast(bf16x8, w);
            }
            asm volatile("s_waitcnt lgkmcnt(0)" ::: "memory");
            __builtin_amdgcn_sched_barrier(0);
#pragma unroll
            for (int s2 = 0; s2 < 2; ++s2)
#pragma unroll
                for (int dvt = 0; dvt < 2; ++dvt) {
                    const s16x4 l = lo[s2 * 2 + dvt], hv = hi[s2 * 2 + dvt];
                    const bf16x8 vf = (bf16x8){l[0], l[1], l[2], l[3], hv[0], hv[1], hv[2], hv[3]};
                    oacc[dvt] = __builtin_amdgcn_mfma_f32_32x32x16_bf16(vf, pf[s2], oacc[dvt], 0, 0, 0);
                }
            __builtin_amdgcn_sched_barrier(0);
        }
        const float inv = 1.0f / ps;
        bf16_t* op = dilp_row(A, pat, tq) + h * 64;
#pragma unroll
        for (int dvt = 0; dvt < 2; ++dvt)
#pragma unroll
            for (int i = 0; i < 4; ++i) {
                u32x2 w; w.x = cvt_pk_bf16(oacc[dvt][4 * i] * inv, oacc[dvt][4 * i + 1] * inv); w.y = cvt_pk_bf16(oacc[dvt][4 * i + 2] * inv, oacc[dvt][4 * i + 3] * inv);
                *(u32x2*)(op + dvt * 32 + 8 * i + 4 * hh) = w;
            }
        if (hh == 0) lse[((size_t)pat * NT + tq) * 8 + h] = mx + __builtin_amdgcn_logf(ps);
        __syncthreads();
    }
#undef DL_PRELOAD
}
__device__ __forceinline__ void merge_scan_phase(const Args& A, int e, int G, int c) {
    int tid_ = threadIdx.x; asm volatile("" : "+v"(tid_));
    const int tid = tid_;
    int nscan = G >= 64 ? 16 : 0;
    const int nmerge = G - nscan;
    if (c >= nmerge || nscan == 0) {
        const int nthr = (nscan ? nscan : G) * 512;
        const int base = (nscan ? (c - nmerge) : c) * 512 + tid;
        const float* sst = (const float*)(A.ws + WS_Z + ZO_SST);
        bf16_t* ug = (bf16_t*)(A.ws + WS_Z + ZO_UG);
        const float* al = (const float*)(A.ws + WS_AL) + (size_t)e * 32 * 128;
        for (int id = base; id < 8192; id += nthr) {
            const int p = id & 63, g = (id >> 6) & 31, b = id >> 11;
            const float ar = al[g * 128 + p], ai = al[g * 128 + 64 + p];
            float hr = 0.f, hi = 0.f;
            const size_t row0 = (size_t)g * NCHUNK + (size_t)b * CPB;
            for (int n0 = 0; n0 < CPB; n0 += 8) {
                float sr[8], si[8];
#pragma unroll
                for (int k = 0; k < 8; ++k) { sr[k] = sst[(row0 + n0 + k) * 128 + p]; si[k] = sst[(row0 + n0 + k) * 128 + 64 + p]; }
#pragma unroll
                for (int k = 0; k < 8; ++k) {
                    bf16_t* up = ug + (row0 + n0 + k) * UGP + 512 + p;
                    up[0] = f2bf(hr); up[64] = f2bf(hi);
                    const float t = ar * hr - ai * hi + sr[k]; hi = ar * hi + ai * hr + si[k]; hr = t;
                }
            }
        }
        if (nscan) return;
    }
    const float* lse = lse_base(A);
    bf16_t* mixed = (bf16_t*)(A.ws + WS_MIXED);
    const int total = NT * 64;
    for (int i = c * 512 + tid; i < total; i += nmerge * 512) {
        const int t = i >> 6, ch = i & 63, h = ch >> 3;
        const float l0 = lse[((size_t)0 * NT + t) * 8 + h], l1 = lse[((size_t)1 * NT + t) * 8 + h], l2 = lse[((size_t)2 * NT + t) * 8 + h];
        const float m = fmaxf(l0, fmaxf(l1, l2));
        float a0 = __builtin_amdgcn_exp2f(l0 - m), a1 = __builtin_amdgcn_exp2f(l1 - m), a2 = __builtin_amdgcn_exp2f(l2 - m);
        const float inv = 1.0f / (a0 + a1 + a2); a0 *= inv; a1 *= inv; a2 *= inv;
        const u32x4 p0 = *(const u32x4*)(dilp_row(A, 0, t) + ch * 8), p1 = *(const u32x4*)(dilp_row(A, 1, t) + ch * 8), p2 = *(const u32x4*)(dilp_row(A, 2, t) + ch * 8);
        u32x4 w;
#pragma unroll
        for (int k = 0; k < 4; ++k) {
            const float lo = a0 * __uint_as_float(p0[k] << 16) + a1 * __uint_as_float(p1[k] << 16) + a2 * __uint_as_float(p2[k] << 16);
            const float hi = a0 * __uint_as_float(p0[k] & 0xffff0000u) + a1 * __uint_as_float(p1[k] & 0xffff0000u) + a2 * __uint_as_float(p2[k] & 0xffff0000u);
            w[k] = cvt_pk_bf16(lo, hi);
        }
        *(u32x4*)(mixed + (size_t)t * 1024 + 512 + ch * 8) = w;
    }
}

__device__ __forceinline__ void final_phase(const Args& A, int G, int c) {
    int tid_ = threadIdx.x; asm volatile("" : "+v"(tid_));
    const int tid = tid_, lane = tid & 63, wid = tid >> 6;
    const float* ss = (const float*)(A.ws + WS_SS);
    const bf16_t* hi = (const bf16_t*)(A.ws + WS_XB);
    const float* gw = (const float*)(A.ws + WS_MISC) + 1024;
    for (int row = c * 8 + wid; row < NT; row += G * 8) {
        const float rs = row_rs(ss, row);
        float* xr = A.out + (size_t)row * 1024;
        const bf16_t* hr = hi + (size_t)row * 1024; const bf16_t* lr = lo_row(A.out, row);
        u32x2 hv[4], lv[4];
#pragma unroll
        for (int i = 0; i < 4; ++i) { hv[i] = *(const u32x2*)(hr + i * 256 + lane * 4); if (RES_LO) lv[i] = *(const u32x2*)(lr + i * 256 + lane * 4); else { lv[i].x = 0u; lv[i].y = 0u; } }
        f32x4 v[4];
#pragma unroll
        for (int i = 0; i < 4; ++i) {
            const f32x4 g = *(const f32x4*)(gw + i * 256 + lane * 4);
            v[i][0] = (__uint_as_float(hv[i].x << 16) + __uint_as_float(lv[i].x << 16)) * rs * g[0];
            v[i][1] = (__uint_as_float(hv[i].x & 0xffff0000u) + __uint_as_float(lv[i].x & 0xffff0000u)) * rs * g[1];
            v[i][2] = (__uint_as_float(hv[i].y << 16) + __uint_as_float(lv[i].y << 16)) * rs * g[2];
            v[i][3] = (__uint_as_float(hv[i].y & 0xffff0000u) + __uint_as_float(lv[i].y & 0xffff0000u)) * rs * g[3];
        }
        asm volatile("s_waitcnt vmcnt(0)" ::: "memory");
#pragma unroll
        for (int i = 0; i < 4; ++i) *(f32x4*)(xr + i * 256 + lane * 4) = v[i];
    }
}

#define XB_TMO      128
#define XB_XCNT(j)  (256  + 64 * (j))
#define XB_XSUB(j)  (1280 + 64 * (j))
#define XB_XGEN(j)  (2304 + 64 * (j))
#define XB_TOP      3328
#define XB_TOPGEN   3392
#define XCD_BAR_WORDS 3456
#define XB_SPIN_CAP (1u << 22)
__device__ __forceinline__ unsigned xb_ld(unsigned* p)              { return __hip_atomic_load(p, __ATOMIC_RELAXED, __HIP_MEMORY_SCOPE_AGENT); }
__device__ __forceinline__ unsigned xb_add(unsigned* p, unsigned v) { return __hip_atomic_fetch_add(p, v, __ATOMIC_RELAXED, __HIP_MEMORY_SCOPE_AGENT); }
__device__ __forceinline__ unsigned xb_xcc_id() { return (unsigned)__builtin_amdgcn_s_getreg((3 << 11) | 20) & 0xFu; }
#define XB_SPIN(cond, bar) do { unsigned _sp = 0; while (cond) { __builtin_amdgcn_s_sleep(1); \
    if ((++_sp & 255u) == 0u) { if (xb_ld(&(bar)[XB_TMO])) break; if (_sp > XB_SPIN_CAP) { atomicAdd(&(bar)[XB_TMO], 1u); break; } } } } while (0)
struct XcdBarrier { unsigned* bar; unsigned x; volatile LAS unsigned* st; };
__device__ __forceinline__ XcdBarrier xcd_barrier_post(unsigned* bar, volatile LAS unsigned* st) {
    XcdBarrier b; b.bar = bar; b.x = xb_xcc_id(); b.st = st;
    if (threadIdx.x == 0) (void)xb_add(&bar[XB_XCNT(b.x)], 1u);
    return b;
}
__device__ __forceinline__ void xcd_barrier_complete(unsigned* bar, unsigned x, unsigned& nloc, unsigned& nx) {
    const unsigned G = gridDim.x * gridDim.y * gridDim.z;
    unsigned sum, cnt, mine, sp = 0u;
    for (;;) {
        sum = 0u; cnt = 0u; mine = 0u;
#pragma unroll
        for (unsigned j = 0; j < 16; ++j) { const unsigned c = xb_ld(&bar[XB_XCNT(j)]); sum += c; cnt += (c > 0u) ? 1u : 0u; mine = (j == x) ? c : mine; }
        if (sum == G) break;
        __builtin_amdgcn_s_sleep(1);
        if ((++sp & 255u) == 0u) { if (xb_ld(&bar[XB_TMO])) break; if (sp > XB_SPIN_CAP) { atomicAdd(&bar[XB_TMO], 1u); break; } }
    }
    nloc = mine > 0u ? mine : 1u; nx = cnt > 0u ? cnt : 1u;
}
__device__ __forceinline__ void xcd_barrier(unsigned* bar_, volatile LAS unsigned* st_) {
    XcdBarrier b; b.bar = bar_; b.x = xb_xcc_id(); b.st = st_;
    asm volatile("s_waitcnt vmcnt(0)" ::: "memory");
    __syncthreads();
    if (threadIdx.x == 0) {
        unsigned* bar = b.bar;
        __builtin_amdgcn_s_waitcnt(0);
        unsigned nloc = b.st[0], nx = b.st[1];
        if (nloc == 0u) { xcd_barrier_complete(bar, b.x, nloc, nx); b.st[0] = nloc; b.st[1] = nx; }
        const unsigned old = xb_add(&bar[XB_XSUB(b.x)], 1u);
        const unsigned gen = old / nloc;
        if (old + 1u == (gen + 1u) * nloc) {
            __builtin_amdgcn_fence(__ATOMIC_RELEASE, "agent");
            asm volatile("s_waitcnt vmcnt(0)" ::: "memory");
            const unsigned og = xb_add(&bar[XB_TOP], 1u);
            const unsigned tg = og / nx;
            if (og + 1u == (tg + 1u) * nx) xb_add(&bar[XB_TOPGEN], 1u);
            else XB_SPIN(xb_ld(&bar[XB_TOPGEN]) == tg, bar);
            __builtin_amdgcn_fence(__ATOMIC_ACQUIRE, "agent");
            xb_add(&bar[XB_XGEN(b.x)], 1u);
            asm volatile("s_waitcnt vmcnt(0)" ::: "memory");
        } else {
            XB_SPIN(xb_ld(&bar[XB_XGEN(b.x)]) == gen, bar);
            __builtin_amdgcn_fence(__ATOMIC_ACQUIRE, "agent");
            asm volatile("s_waitcnt vmcnt(0)" ::: "memory");
        }
    }
    __syncthreads();
}

__global__ void __launch_bounds__(512, 2) trunk_fwd(Args A) {
    extern __shared__ __attribute__((aligned(16))) unsigned char lds_raw[];
    LAS unsigned char* lds = (LAS unsigned char*)lds_raw;
    cg::grid_group grid = cg::this_grid();
    const int G = gridDim.x, c = blockIdx.x;
    volatile LAS unsigned* bst = (volatile LAS unsigned*)(lds + LDS_BARW);
    if (threadIdx.x == 0) { bst[0] = 0u; bst[1] = 0u; }
    __syncthreads();
    (void)xcd_barrier_post((unsigned*)(A.ws + WS_BAR), bst);
    if (A.ws == nullptr) grid.sync();
    unsigned char* ws = A.ws;
    float* ss = (float*)(ws + WS_SS);
    bf16_t* xb = (bf16_t*)(ws + WS_XB);
    bf16_t* mixed = (bf16_t*)(ws + WS_MIXED);
    bf16_t* zb = (bf16_t*)(ws + WS_Z);

#ifndef SKIP_PREP
    prep_phase(A, lds, G, c);
#endif
    xcd_barrier((unsigned*)(A.ws + WS_BAR), (volatile LAS unsigned*)(lds + LDS_BARW));

    for (int layer = 0; layer < 4; ++layer) {
        const int e = layer >> 1;
        if ((layer & 1) == 0) {
            {
                pg8::Gemm g{xb, (const bf16_t*)(ws + WS_EIN + e * SZ_EIN), 1024, 1024, 1024}; pg8::StaticOrder S; S.init(NT, 2048, G, c);
                EpiIn<1> E{ss, zb, (bf16_t*)(ws + WS_Z + ZO_UG)};
                pg8::gemm_phase(lds, g, S, E);
            }
            xcd_barrier((unsigned*)(A.ws + WS_BAR), (volatile LAS unsigned*)(lds + LDS_BARW));
            {
                pg8::Gemm g{(const bf16_t*)(ws + WS_Z + ZO_UG), (const bf16_t*)(ws + WS_BTF + e * SZ_BTF), UGP, 512, 512};
                pg8::GroupOrder S{128, G, c, 4, 1};
                EpiS5State E{(float*)(ws + WS_Z + ZO_SST)};
                pg8::gemm_phase(lds, g, S, E);
                __syncthreads();
#ifndef SKIP_DIL
                dilated_phase(A, lds, G, c);
#endif
            }
            xcd_barrier((unsigned*)(A.ws + WS_BAR), (volatile LAS unsigned*)(lds + LDS_BARW));
#ifndef SKIP_MS
            merge_scan_phase(A, e, G, c);
#endif
            xcd_barrier((unsigned*)(A.ws + WS_BAR), (volatile LAS unsigned*)(lds + LDS_BARW));
            {
                pg8::Gemm g{(const bf16_t*)(ws + WS_Z + ZO_UG), (const bf16_t*)(ws + WS_BTY + e * SZ_BTY), UGP, 640, 640};
                pg8::GroupOrder S{256, G, c, 4, 2};
                EpiS5Y E{(bf16_t*)(ws + WS_Z + ZO_YG)};
                pg8::gemm_phase(lds, g, S, E);
            }
            xcd_barrier((unsigned*)(A.ws + WS_BAR), (volatile LAS unsigned*)(lds + LDS_BARW));
            {
                pg8::Gemm g{(const bf16_t*)(ws + WS_Z + ZO_YG), (const bf16_t*)(ws + WS_GLU + e * SZ_GLU), 512, 512, 512}; pg8::StaticOrder S; S.init(NT, 512, G, c);
                EpiGLU E{(const bf16_t*)(ws + WS_Z + ZO_YG), (const float*)(ws + WS_MISC) + 2048 + e * 512, mixed};
                pg8::gemm_phase(lds, g, S, E);
            }
            xcd_barrier((unsigned*)(A.ws + WS_BAR), (volatile LAS unsigned*)(lds + LDS_BARW));
            {
                pg8::Gemm g{mixed, (const bf16_t*)(ws + WS_EOUT + e * SZ_SQ), 1024, 1024, 1024}; pg8::StaticOrder S; S.init(NT, 1024, G, c);
                if (layer == 0) { EpiRes<true> E{A.in[0], xb, A.out, ss}; pg8::gemm_phase(lds, g, S, E); }
                else { EpiRes<false> E{nullptr, xb, A.out, ss}; pg8::gemm_phase(lds, g, S, E); }
            }
            xcd_barrier((unsigned*)(A.ws + WS_BAR), (volatile LAS unsigned*)(lds + LDS_BARW));
        } else {
            {
                pg8::Gemm g{xb, (const bf16_t*)(ws + WS_OIN + e * SZ_OIN), 1024, 1024, 1024}; pg8::StaticOrder S; S.init(NT, 3072, G, c);
                EpiIn<0> E{ss, zb, nullptr};
                pg8::gemm_phase(lds, g, S, E);
            }
            xcd_barrier((unsigned*)(A.ws + WS_BAR), (volatile LAS unsigned*)(lds + LDS_BARW));
#ifndef SKIP_DIFF
            diff_attn_phase(A, lds, e, G, c);
#endif
            xcd_barrier((unsigned*)(A.ws + WS_BAR), (volatile LAS unsigned*)(lds + LDS_BARW));
            {
                pg8::Gemm g{mixed, (const bf16_t*)(ws + WS_OOUT + e * SZ_SQ), 1024, 1024, 1024}; pg8::StaticOrder S; S.init(NT, 1024, G, c);
                EpiRes<false> E{nullptr, xb, A.out, ss};
                pg8::gemm_phase(lds, g, S, E);
            }
            xcd_barrier((unsigned*)(A.ws + WS_BAR), (volatile LAS unsigned*)(lds + LDS_BARW));
        }
        {
            pg8::Gemm g{xb, (const bf16_t*)(ws + WS_GU + layer * SZ_GU), 1024, 1024, 1024}; pg8::StaticOrder S; S.init(NT, 5632, G, c);
            EpiSwiGLU E{ss, zb};
            pg8::gemm_phase(lds, g, S, E);
        }
        xcd_barrier((unsigned*)(A.ws + WS_BAR), (volatile LAS unsigned*)(lds + LDS_BARW));
        {
            pg8::Gemm g{zb, (const bf16_t*)(ws + WS_DN + layer * SZ_DN), DFF, DFF, DFF, 1}; pg8::StaticOrder S; S.init(NT, 1024, G, c);
            EpiRes<false> E{nullptr, xb, A.out, ss};
            pg8::gemm_phase(lds, g, S, E);
        }
        xcd_barrier((unsigned*)(A.ws + WS_BAR), (volatile LAS unsigned*)(lds + LDS_BARW));
    }
    final_phase(A, G, c);
}

extern "C" void kernel_launch(void* const* d_in, const int* in_sizes, int n_in, void* d_out, int out_size, void* d_ws, size_t ws_size, hipStream_t stream) {
    static int grid = 0;
    if (grid == 0) {
        if (n_in != 27 || out_size != NT * 1024 || ws_size < WS_END) { fprintf(stderr, "kernel_launch: unexpected shapes (n_in %d out %d ws %zu need %zu)\n", n_in, out_size, ws_size, (size_t)WS_END); grid = -1; return; }
        int dev = 0, cus = 0, per_cu = 0;
        hipGetDevice(&dev);
        hipDeviceGetAttribute(&cus, hipDeviceAttributeMultiprocessorCount, dev);
        if (hipFuncSetAttribute((const void*)trunk_fwd, hipFuncAttributeMaxDynamicSharedMemorySize, LDS_BYTES) != hipSuccess) { fprintf(stderr, "kernel_launch: hipFuncSetAttribute failed\n"); grid = -1; return; }
        if (hipOccupancyMaxActiveBlocksPerMultiprocessor(&per_cu, (const void*)trunk_fwd, 512, LDS_BYTES) != hipSuccess || per_cu < 1) { fprintf(stderr, "kernel_launch: occupancy query says %d\n", per_cu); per_cu = 1; }
        (void)hipGetLastError();
        grid = cus;
    }
    if (grid < 0) return;
    Args a{};
    for (int i = 0; i < 27; ++i) a.in[i] = (const float*)d_in[i];
    a.out = (float*)d_out; a.ws = (unsigned char*)d_ws;
    if (hipMemsetAsync((char*)d_ws + WS_BAR, 0, 16384, stream) != hipSuccess) { fprintf(stderr, "kernel_launch: memset failed\n"); return; }
    void* args[] = {&a};
    hipError_t err = hipLaunchCooperativeKernel((const void*)trunk_fwd, dim3(grid), dim3(512), args, LDS_BYTES, stream);
    if (err != hipSuccess) fprintf(stderr, "cooperative launch failed: %s (grid %d)\n", hipGetErrorString(err), grid);
}
```
